# Optimizing an MI355X kernel written in HIP

```python
import jax, jax.numpy as jnp
from jax import lax
import numpy as np

D_MODEL = 1024
BATCH = 4
SEQ = 4096
DEPTH = 1
DEC_BATCH = 128
DEC_SEQ = 4
PAST_LEN = 16384
PAGE_SIZE = 128

D_MIX = D_MODEL
D_ATTN = D_MIX // 2
D_GMLP = D_MIX - D_ATTN
HEAD_DIM = 64
N_HEADS = D_ATTN // HEAD_DIM
N_KV = 2
GQA = N_HEADS // N_KV
WINDOW = 128
ROPE_THETA = 10000.0
CHUNK = 128
G_DIM = 64
G_HEADS = D_GMLP // G_DIM
D_FF = 2816
EPS = 1e-6
Q_W = N_HEADS * HEAD_DIM
KV_W = N_KV * HEAD_DIM
D_IN = Q_W + 2 * KV_W + 2 * D_GMLP

kernel_name = "hymba_swa_sink_gmlp_macaron_step"


def _rmsnorm(x, g):
    xf = x.astype(jnp.float32)
    y = xf * lax.rsqrt(jnp.mean(xf * xf, axis=-1, keepdims=True) + EPS)
    return (y * g.astype(jnp.float32)).astype(x.dtype)


def _rope(x, pos):
    inv_freq = ROPE_THETA ** (-jnp.arange(0, HEAD_DIM, 2, dtype=jnp.float32) / HEAD_DIM)
    ang = pos.astype(jnp.float32)[:, None] * inv_freq[None, :]
    c = jnp.cos(ang)[:, None, :]
    s = jnp.sin(ang)[:, None, :]
    xf = x.astype(jnp.float32)
    x1, x2 = xf[..., :HEAD_DIM // 2], xf[..., HEAD_DIM // 2:]
    return jnp.concatenate([x1 * c - x2 * s, x2 * c + x1 * s], axis=-1).astype(x.dtype)


def _ffn_half(x, g, wg, wu, wd):
    h = _rmsnorm(x, g)
    return x + 0.5 * ((jax.nn.silu(h @ wg) * (h @ wu)) @ wd)


def _in_proj(h, w_in, g_v):
    z = h @ w_in
    lead = z.shape[:-1]
    i1 = Q_W
    i2 = i1 + KV_W
    i3 = i2 + KV_W
    i4 = i3 + D_GMLP
    q = z[..., :i1].reshape(*lead, N_HEADS, HEAD_DIM)
    k = z[..., i1:i2].reshape(*lead, N_KV, HEAD_DIM)
    v = z[..., i2:i3].reshape(*lead, N_KV, HEAD_DIM)
    u = jax.nn.gelu(z[..., i3:i4])
    gv = _rmsnorm(jax.nn.gelu(z[..., i4:]), g_v).reshape(*lead, G_HEADS, G_DIM)
    return q, k, v, u, gv


def _sink_attend(q, k, v, valid, sinks):
    s = jnp.einsum('...qkgd,...skd->...kgqs', q, k).astype(jnp.float32) * (HEAD_DIM ** -0.5)
    s = jnp.where(valid, s, -jnp.inf)
    sink = jnp.broadcast_to(sinks.astype(jnp.float32).reshape(N_KV, GQA, 1, 1), s.shape[:-1] + (1,))
    p = jax.nn.softmax(jnp.concatenate([s, sink], axis=-1), axis=-1)[..., :-1]
    return jnp.einsum('...kgqs,...skd->...qkgd', p.astype(v.dtype), v)


def _swa_prompt(q, k, v, sinks):
    B, S = q.shape[:2]
    nb = S // WINDOW
    qb = q.reshape(B, nb, WINDOW, N_KV, GQA, HEAD_DIM)
    kp = jnp.pad(k, ((0, 0), (WINDOW, 0), (0, 0), (0, 0)))
    vp = jnp.pad(v, ((0, 0), (WINDOW, 0), (0, 0), (0, 0)))
    kb = jnp.concatenate([kp[:, :S].reshape(B, nb, WINDOW, N_KV, HEAD_DIM),
                          k.reshape(B, nb, WINDOW, N_KV, HEAD_DIM)], axis=2)
    vb = jnp.concatenate([vp[:, :S].reshape(B, nb, WINDOW, N_KV, HEAD_DIM),
                          v.reshape(B, nb, WINDOW, N_KV, HEAD_DIM)], axis=2)
    qi = jnp.arange(WINDOW)
    sj = jnp.arange(2 * WINDOW)
    n = jnp.arange(nb)
    dist = WINDOW + qi[:, None] - sj[None, :]
    kpos = (n[:, None] - 1) * WINDOW + sj[None, :]
    valid = ((dist >= 0) & (dist < WINDOW))[None] & (kpos >= 0)[:, None, :]
    o = _sink_attend(qb, kb, vb, valid[None, :, None, None], sinks)
    return o.reshape(B, S, Q_W)


def _swa_sample(q, k_all, v_all, kpos, qpos, sinks):
    Bd, T = q.shape[:2]
    qg = q.reshape(Bd, T, N_KV, GQA, HEAD_DIM)
    dist = qpos[:, None] - kpos[None, :]
    valid = (dist >= 0) & (dist < WINDOW)
    o = _sink_attend(qg, k_all, v_all, valid, sinks)
    return o.reshape(Bd, T, Q_W)


def _gmlp(u, gv, ws, b_s):
    B, L = u.shape[:2]
    c = min(L, CHUNK)
    vb = gv.reshape(B, L // c, c, G_HEADS, G_DIM)
    mixed = jnp.einsum('hts,bnshd->bnthd', ws[:, :c, :c], vb) + b_s[:, :c].T[None, None, :, :, None]
    return u * mixed.reshape(B, L, D_GMLP)


def _out_proj(ya, yg, g_a, g_g, w_out):
    return jnp.concatenate([_rmsnorm(ya, g_a), _rmsnorm(yg, g_g)], axis=-1) @ w_out


def setup_inputs(seed: int = 0) -> dict:
    key = jax.random.key(seed)
    ks = jax.random.split(key, 24)
    f32 = jnp.float32
    w_buf = min(WINDOW, PAST_LEN)

    def nrm(k, shape, scale):
        return jax.random.normal(k, shape, f32) * scale

    def gain(k, shape):
        return 1.0 + 0.02 * jax.random.normal(k, shape, f32)

    return {
        "x_prompt": nrm(ks[0], (BATCH, SEQ, D_MODEL), 1.0),
        "x_sample": nrm(ks[1], (DEC_BATCH, DEC_SEQ, D_MODEL), 1.0),
        "cache_k_win": nrm(ks[2], (DEPTH, DEC_BATCH, w_buf, N_KV, HEAD_DIM), 1.0),
        "cache_v_win": nrm(ks[3], (DEPTH, DEC_BATCH, w_buf, N_KV, HEAD_DIM), 1.0),
        "norm_ffn1": gain(ks[4], (DEPTH, D_MODEL)),
        "ffn1_gate": nrm(ks[5], (DEPTH, D_MODEL, D_FF), D_MODEL ** -0.5),
        "ffn1_up": nrm(ks[6], (DEPTH, D_MODEL, D_FF), D_MODEL ** -0.5),
        "ffn1_down": nrm(ks[7], (DEPTH, D_FF, D_MODEL), D_FF ** -0.5),
        "norm_mix": gain(ks[8], (DEPTH, D_MODEL)),
        "w_in": nrm(ks[9], (DEPTH, D_MODEL, D_IN), D_MODEL ** -0.5),
        "attn_sinks": nrm(ks[10], (DEPTH, N_HEADS), 0.5),
        "gmlp_v_norm": gain(ks[11], (DEPTH, D_GMLP)),
        "gmlp_w_s": nrm(ks[12], (DEPTH, G_HEADS, CHUNK, CHUNK), CHUNK ** -0.5),
        "gmlp_b_s": gain(ks[13], (DEPTH, G_HEADS, CHUNK)),
        "norm_attn_out": gain(ks[14], (DEPTH, D_ATTN)),
        "norm_gmlp_out": gain(ks[15], (DEPTH, D_GMLP)),
        "w_out": nrm(ks[16], (DEPTH, D_MIX, D_MODEL), D_MIX ** -0.5),
        "norm_ffn2": gain(ks[17], (DEPTH, D_MODEL)),
        "ffn2_gate": nrm(ks[18], (DEPTH, D_MODEL, D_FF), D_MODEL ** -0.5),
        "ffn2_up": nrm(ks[19], (DEPTH, D_MODEL, D_FF), D_MODEL ** -0.5),
        "ffn2_down": nrm(ks[20], (DEPTH, D_FF, D_MODEL), D_FF ** -0.5),
        "norm_final": gain(ks[21], (D_MODEL,)),
    }


def reference(x_prompt, x_sample, cache_k_win, cache_v_win, norm_ffn1, ffn1_gate, ffn1_up, ffn1_down,
              norm_mix, w_in, attn_sinks, gmlp_v_norm, gmlp_w_s, gmlp_b_s, norm_attn_out, norm_gmlp_out,
              w_out, norm_ffn2, ffn2_gate, ffn2_up, ffn2_down, norm_final):
    S = x_prompt.shape[1]
    T = x_sample.shape[1]
    w_buf = cache_k_win.shape[2]
    pos_p = jnp.arange(S, dtype=jnp.int32)
    pos_s = PAST_LEN + jnp.arange(T, dtype=jnp.int32)
    kpos_s = jnp.concatenate([PAST_LEN - w_buf + jnp.arange(w_buf, dtype=jnp.int32), pos_s])
    tril = jnp.tril(jnp.ones((CHUNK, CHUNK), dtype=bool))

    hp, hs = x_prompt, x_sample
    kwp, vwp, kws, vws, gvp, gvs = [], [], [], [], [], []
    for l in range(DEPTH):
        hp = _ffn_half(hp, norm_ffn1[l], ffn1_gate[l], ffn1_up[l], ffn1_down[l])
        hs = _ffn_half(hs, norm_ffn1[l], ffn1_gate[l], ffn1_up[l], ffn1_down[l])
        ws = jnp.where(tril, gmlp_w_s[l], jnp.zeros((), gmlp_w_s.dtype))

        q, k, v, u, gv = _in_proj(_rmsnorm(hp, norm_mix[l]), w_in[l], gmlp_v_norm[l])
        q = _rope(q, pos_p)
        k = _rope(k, pos_p)
        ya = _swa_prompt(q, k, v, attn_sinks[l])
        yg = _gmlp(u, gv, ws, gmlp_b_s[l])
        hp = hp + _out_proj(ya, yg, norm_attn_out[l], norm_gmlp_out[l], w_out[l])
        kwp.append(k[:, -min(WINDOW, S):])
        vwp.append(v[:, -min(WINDOW, S):])
        gvp.append(gv[:, -CHUNK:])

        q, k, v, u, gv = _in_proj(_rmsnorm(hs, norm_mix[l]), w_in[l], gmlp_v_norm[l])
        q = _rope(q, pos_s)
        k = _rope(k, pos_s)
        k_all = jnp.concatenate([cache_k_win[l].astype(k.dtype), k], axis=1)
        v_all = jnp.concatenate([cache_v_win[l].astype(v.dtype), v], axis=1)
        ya = _swa_sample(q, k_all, v_all, kpos_s, pos_s, attn_sinks[l])
        yg = _gmlp(u, gv, ws, gmlp_b_s[l])
        hs = hs + _out_proj(ya, yg, norm_attn_out[l], norm_gmlp_out[l], w_out[l])
        kws.append(k_all[:, -w_buf:])
        vws.append(v_all[:, -w_buf:])
        gvs.append(gv)

        hp = _ffn_half(hp, norm_ffn2[l], ffn2_gate[l], ffn2_up[l], ffn2_down[l])
        hs = _ffn_half(hs, norm_ffn2[l], ffn2_gate[l], ffn2_up[l], ffn2_down[l])

    y_prompt = _rmsnorm(hp, norm_final)
    y_sample = _rmsnorm(hs, norm_final)
    return (y_prompt, y_sample, jnp.stack(kwp), jnp.stack(vwp), jnp.stack(kws), jnp.stack(vws),
            jnp.stack(gvp), jnp.stack(gvs))
```

```cpp
#include <hip/hip_runtime.h>
#include <cstdio>
#include <cstdint>
#include <cmath>
namespace pg8 {
#define PG8_LAS __attribute__((address_space(3)))
typedef unsigned short bf16_t;
typedef short bf16x8 __attribute__((ext_vector_type(8)));
typedef float f32x4 __attribute__((ext_vector_type(4)));
typedef unsigned u32x4 __attribute__((ext_vector_type(4)));
constexpr int BM = 256, BK = 64, HALF = 128, HTB = HALF * BK * 2  , STAGE_BYTES = 8 * HTB, NXCD = 8, WGM = 8;

__host__ __device__ __forceinline__ int lds_byte(int r, int c) { const int st = (r >> 4) * 2 + (c >> 5), rr = r & 15, cc = c & 31, ob = rr * 64 + cc * 2; return st * 1024 + (ob ^ (((ob >> 9) & 1) << 5)); }
__host__ __device__ __forceinline__ void stage_rc(int b, int& R, int& C) { const int st = b / 1024, sb = b % 1024, swz = sb ^ (((sb >> 9) & 1) << 5); R = (st >> 1) * 16 + swz / 64; C = (st & 1) * 32 + (swz % 64) / 2; }
__host__ __device__ __forceinline__ int perm32(int rho) { const int n = rho >> 4, i = rho & 15; return 8 * (i >> 2) + 4 * n + (i & 3); }

struct Unit { int pm, pn; };
struct Gemm { const bf16_t* A; const bf16_t* Bt; int M, N, K; };

struct StaticOrder {
    int nM, nN, nwg, G, c;
    __host__ __device__ void init(int M, int N, int G_, int c_) { nM = M / BM; nN = N / BM; nwg = nM * nN; G = G_; c = c_; }
    __host__ __device__ bool next(int i, Unit& u) const {
        const long L = (long)i * G + c; if (L >= nwg) return false;
        int wgid = (int)L; { const int q = nwg / NXCD, r = nwg % NXCD, xcd = wgid % NXCD, off = wgid / NXCD; wgid = (xcd < r ? xcd * (q + 1) : r * (q + 1) + (xcd - r) * q) + off; }
        const int nig = WGM * nN, gid = wgid / nig, fm = gid * WGM, gsz = (nM - fm) < WGM ? (nM - fm) : WGM;
        u.pm = fm + ((wgid % nig) % gsz); u.pn = (wgid % nig) / gsz; return true;
    }
    __device__ __forceinline__ void a_ready(const Unit&) const {}
    __device__ __forceinline__ void done(const Unit&) const {}
};

__device__ __forceinline__ unsigned cvt_pk_bf16(float lo, float hi) { unsigned r; asm volatile("v_cvt_pk_bf16_f32 %0, %1, %2" : "=v"(r) : "v"(lo), "v"(hi)); return r; }
typedef float f32x2 __attribute__((ext_vector_type(2)));
constexpr float LOG2E = 1.4426950408889634f;
constexpr float RMS_EPS = 1e-6f;
__device__ __forceinline__ float xsum4(float s) { s += __shfl_xor(s, 16); s += __shfl_xor(s, 32); return s; }
__device__ __forceinline__ float row_rscale16(const float* ss, int row, int fq) {
    const f32x4 v = *(const f32x4*)(ss + (size_t)row * 16 + 4 * fq);
    const float s = xsum4((v[0] + v[1]) + (v[2] + v[3]));
    return __builtin_amdgcn_rsqf(s * (1.0f / 1024.0f) + RMS_EPS);
}
__device__ __forceinline__ float silu_mul(float g, float u) { return g * u * __builtin_amdgcn_rcpf(1.0f + __builtin_amdgcn_exp2f(-LOG2E * g)); }
__device__ __forceinline__ float gelu_tanh(float x) {
    const float t = x * (1.0f + 0.044715f * x * x);
    return x * __builtin_amdgcn_rcpf(1.0f + __builtin_amdgcn_exp2f(-2.0f * 0.7978845608028654f * LOG2E * t));
}
__device__ __forceinline__ u32x4 pack8(const f32x4& a, const f32x4& b) { u32x4 w; w.x = cvt_pk_bf16(a[0], a[1]); w.y = cvt_pk_bf16(a[2], a[3]); w.z = cvt_pk_bf16(b[0], b[1]); w.w = cvt_pk_bf16(b[2], b[3]); return w; }

template <bool SCALED> struct EpiSwiGLU {
    static constexpr bool PERM = true, AFTER_DRAIN = false;
    bf16_t* H; int ldh; const float* ss;
    __device__ __forceinline__ void operator()(const f32x4 (&acc)[2][2][4][2], const Unit& u, int wr, int wc, int fr, int fq) const {
        const int row0 = u.pm * BM + wr * 64 + fr, col0 = u.pn * HALF + wc * 32 + 8 * fq;
#pragma unroll
        for (int ai = 0; ai < 2; ++ai)
#pragma unroll
            for (int m = 0; m < 4; ++m) { const int row = row0 + ai * HALF + m * 16;
                float rs = 1.0f; if (SCALED) rs = row_rscale16(ss, row, fq);
                f32x4 h[2];
#pragma unroll
                for (int n = 0; n < 2; ++n) { const f32x4 g = acc[ai][0][m][n] * rs, v = acc[ai][1][m][n] * rs;
#pragma unroll
                    for (int i = 0; i < 4; ++i) h[n][i] = silu_mul(g[i], v[i]); }
                *(u32x4*)(H + (size_t)row * ldh + col0) = pack8(h[0], h[1]); }
    }
};

template <bool WB> struct EpiRes {
    static constexpr bool PERM = true, AFTER_DRAIN = false;
    const float* res_p; const float* res_s;
    int split_pm; float* X; bf16_t* XB; float* ss; float scale;
    __device__ __forceinline__ void operator()(const f32x4 (&acc)[2][2][4][2], const Unit& u, int wr, int wc, int fr, int fq) const {
        const int row0 = u.pm * BM + wr * 64 + fr, col0 = u.pn * BM + wc * 32 + 8 * fq;
        const float* rb = (u.pm < split_pm) ? res_p : res_s;
#pragma unroll
        for (int ai = 0; ai < 2; ++ai)
#pragma unroll
            for (int m = 0; m < 4; ++m) { const int row = row0 + ai * HALF + m * 16; const size_t off = (size_t)row * 1024 + col0; float q = 0.f;
#pragma unroll
                for (int bj = 0; bj < 2; ++bj) {
                    const f32x4 r0 = *(const f32x4*)(rb + off + bj * HALF), r1 = *(const f32x4*)(rb + off + bj * HALF + 4);
                    const f32x4 o0 = r0 + acc[ai][bj][m][0] * scale, o1 = r1 + acc[ai][bj][m][1] * scale;
                    q += (o0[0] * o0[0] + o0[1] * o0[1]) + (o0[2] * o0[2] + o0[3] * o0[3]); q += (o1[0] * o1[0] + o1[1] * o1[1]) + (o1[2] * o1[2] + o1[3] * o1[3]);
                    *(f32x4*)(X + off + bj * HALF) = o0; *(f32x4*)(X + off + bj * HALF + 4) = o1;
                    if (WB) *(u32x4*)(XB + off + bj * HALF) = pack8(o0, o1); }
                q = xsum4(q);
                if (fq == 0) ss[(size_t)row * 16 + u.pn * 4 + wc] = q; }
    }
};

struct EpiInProj {
    static constexpr bool PERM = true, AFTER_DRAIN = false;
    bf16_t* Z; const float* ss1; const float* rope; float* ssv; float* outb; long o_kp, o_ks, d_p, d_s;
    __device__ __forceinline__ void operator()(const f32x4 (&acc)[2][2][4][2], const Unit& u, int wr, int wc, int fr, int fq) const {
        const int row0 = u.pm * BM + wr * 64 + fr, pn = u.pn, cb = pn * BM + wc * 64 + 8 * fq;
        const bool rot = (pn < 2) || (pn == 2 && wc < 2);
#pragma unroll
        for (int ai = 0; ai < 2; ++ai)
#pragma unroll
            for (int m = 0; m < 4; ++m) { const int row = row0 + ai * HALF + m * 16;
                const float rs = row_rscale16(ss1, row, fq);
                f32x4 a0 = acc[ai][0][m][0] * rs, a1 = acc[ai][0][m][1] * rs, b0 = acc[ai][1][m][0] * rs, b1 = acc[ai][1][m][1] * rs;
                if (rot) {
                    const int pi = (row < 16384) ? (row & 4095) : (4096 + (row & 3));
                    const float* ct = rope + (size_t)pi * 64 + 8 * fq;
                    const f32x4 c0 = *(const f32x4*)(ct), c1 = *(const f32x4*)(ct + 4), s0 = *(const f32x4*)(ct + 32), s1 = *(const f32x4*)(ct + 36);
                    const f32x4 x0 = a0 * c0 - b0 * s0, x1 = a1 * c1 - b1 * s1, y0 = b0 * c0 + a0 * s0, y1 = b1 * c1 + a1 * s1;
                    a0 = x0; a1 = x1; b0 = y0; b1 = y1;
                    if (pn < 2) { const float qs = 0.125f * LOG2E; a0 = a0 * qs; a1 = a1 * qs; b0 = b0 * qs; b1 = b1 * qs; }
                } else if (pn >= 3) {
#pragma unroll
                    for (int i = 0; i < 4; ++i) { a0[i] = gelu_tanh(a0[i]); a1[i] = gelu_tanh(a1[i]); b0[i] = gelu_tanh(b0[i]); b1[i] = gelu_tanh(b1[i]); }
                    if (pn >= 5) {
                        float q = (a0[0] * a0[0] + a0[1] * a0[1]) + (a0[2] * a0[2] + a0[3] * a0[3]); q += (a1[0] * a1[0] + a1[1] * a1[1]) + (a1[2] * a1[2] + a1[3] * a1[3]);
                        q += (b0[0] * b0[0] + b0[1] * b0[1]) + (b0[2] * b0[2] + b0[3] * b0[3]); q += (b1[0] * b1[0] + b1[1] * b1[1]) + (b1[2] * b1[2] + b1[3] * b1[3]);
                        q = xsum4(q);
                        if (fq == 0) ssv[(size_t)row * 8 + (pn - 5) * 4 + wc] = q; }
                }
                if (pn == 2) {
                    const bool smp = (u.pm >= 64); float* ob = outb + (smp ? o_ks : o_kp) + ((wc >= 2) ? (smp ? d_s : d_p) : 0); const int kvh = wc & 1; bool wr_ = false; size_t o = 0;
                    if (u.pm >= 64) { const int bs = (row - 16384) >> 2, t = row & 3; o = ((size_t)(bs * 128 + 124 + t) * 2 + kvh) * 64 + 8 * fq; wr_ = true; }
                    else if ((u.pm & 15) == 15 && ai == 1) { const int bp = row >> 12, t = (row & 4095) - 3968; o = ((size_t)(bp * 128 + t) * 2 + kvh) * 64 + 8 * fq; wr_ = true; }
                    if (wr_) { *(f32x4*)(ob + o) = a0; *(f32x4*)(ob + o + 4) = a1; *(f32x4*)(ob + o + 32) = b0; *(f32x4*)(ob + o + 36) = b1; }
                }
                bf16_t* zr = Z + (size_t)row * 1792 + cb;
                *(u32x4*)(zr) = pack8(a0, a1); *(u32x4*)(zr + 32) = pack8(b0, b1); }
    }
};
template <class Epi, class Sched, bool ALIGN_EPI = false, bool SP2 = false>
__device__ __forceinline__ void gemm_phase(PG8_LAS unsigned char* lds, const Gemm g, const Sched& S, const Epi& E) {
    const int tid = threadIdx.x, wid = __builtin_amdgcn_readfirstlane(tid >> 6), lane = tid & 63, wr = wid >> 2, wc = wid & 3, fr = lane & 15, fq = lane >> 4;
    const int K = g.K, nt = K / BK;
    unsigned voffA[2], voffB[2];
#pragma unroll
    for (int i = 0; i < 2; ++i) { int R, C; stage_rc(tid * 16 + i * 8192, R, C); const int Rb = Epi::PERM ? ((R & ~31) + perm32(R & 31)) : R;
        voffA[i] = (unsigned)(R * K + C) * 2u; voffB[i] = (unsigned)(Rb * K + C) * 2u; }
    const size_t kstep = (size_t)(BK * 2);
    const size_t hstep = (size_t)HALF * K * 2;
    const size_t tstep = 2 * hstep;
    const unsigned ldsw = (unsigned)wid * 1024u;
    const int aoff = lds_byte(wr * 64 + fr, fq * 8), boff = lds_byte(wc * 32 + fr, fq * 8);
#define PG8_SA(b, h) (((b) * 2 + (h)) * HTB)
#define PG8_SB(b, h) ((4 + (b) * 2 + (h)) * HTB)
#define PG8_STAGE(bufoff, gbase, voff) do { _Pragma("unroll") for (int _i = 0; _i < 2; ++_i) \
        __builtin_amdgcn_global_load_lds((const unsigned*)((const char*)(gbase) + (voff)[_i]), (PG8_LAS unsigned*)(lds + (bufoff) + ldsw + _i * 8192), 16, 0, 0); } while (0)
#define PG8_LDA(dst, b, h) do { _Pragma("unroll") for (int m = 0; m < 4; ++m) _Pragma("unroll") for (int k = 0; k < 2; ++k) dst[m][k] = *(const PG8_LAS bf16x8*)(lds + PG8_SA(b, h) + aoff + m * 2048 + k * 1024); } while (0)
#define PG8_LDB(dst, b, h) do { _Pragma("unroll") for (int n = 0; n < 2; ++n) _Pragma("unroll") for (int k = 0; k < 2; ++k) dst[n][k] = *(const PG8_LAS bf16x8*)(lds + PG8_SB(b, h) + boff + n * 2048 + k * 1024); } while (0)
#define PG8_MMA(ai, bj, At, Bt) do { __builtin_amdgcn_s_setprio(1); _Pragma("unroll") for (int m = 0; m < 4; ++m) _Pragma("unroll") for (int n = 0; n < 2; ++n) _Pragma("unroll") for (int k = 0; k < 2; ++k) \
        acc[ai][bj][m][n] = __builtin_amdgcn_mfma_f32_16x16x32_bf16(Bt[n][k], At[m][k], acc[ai][bj][m][n], 0, 0, 0); __builtin_amdgcn_s_setprio(0); } while (0)
#define PG8_WAIT_V(n) asm volatile("s_waitcnt vmcnt(" #n ")" ::: "memory")
#define PG8_WAIT_L(n) asm volatile("s_waitcnt lgkmcnt(" #n ")" ::: "memory")
#define PG8_BAR __builtin_amdgcn_s_barrier()
#define PG8_SCHED __builtin_amdgcn_sched_barrier(0)
    Unit cur, nxt; int ui = 0;
    if (!S.next(0, cur)) return;
    f32x4 acc[2][2][4][2];
#pragma unroll
    for (int a = 0; a < 2; ++a)
#pragma unroll
        for (int b = 0; b < 2; ++b)
#pragma unroll
            for (int m = 0; m < 4; ++m)
#pragma unroll
                for (int n = 0; n < 2; ++n) acc[a][b][m][n] = (f32x4){0.f, 0.f, 0.f, 0.f};
    bf16x8 At[4][2], B0[2][2], B1[2][2];
    const char* cA = (const char*)g.A + (size_t)cur.pm * tstep; const char* cB = (const char*)g.Bt + (size_t)cur.pn * tstep;
    S.a_ready(cur);
    if constexpr (SP2) {
        PG8_STAGE(PG8_SB(0, 0), cB, voffB); PG8_STAGE(PG8_SB(0, 1), cB + hstep, voffB); PG8_STAGE(PG8_SA(0, 0), cA, voffA); PG8_STAGE(PG8_SA(0, 1), cA + hstep, voffA);
        if (wr == 1) PG8_BAR;
        PG8_WAIT_V(2); PG8_BAR;
        PG8_STAGE(PG8_SB(1, 0), cB + kstep, voffB); PG8_STAGE(PG8_SA(1, 0), cA + kstep, voffA); PG8_STAGE(PG8_SB(1, 1), cB + hstep + kstep, voffB);
        PG8_WAIT_V(6); PG8_BAR;
    } else {
        PG8_STAGE(PG8_SB(0, 0), cB, voffB); PG8_STAGE(PG8_SA(0, 0), cA, voffA); PG8_STAGE(PG8_SB(0, 1), cB + hstep, voffB); PG8_STAGE(PG8_SA(0, 1), cA + hstep, voffA);
        if (wr == 1) PG8_BAR;
        PG8_WAIT_V(4); PG8_BAR;
        PG8_STAGE(PG8_SB(1, 0), cB + kstep, voffB); PG8_STAGE(PG8_SA(1, 0), cA + kstep, voffA); PG8_STAGE(PG8_SB(1, 1), cB + hstep + kstep, voffB);
        PG8_WAIT_V(6); PG8_BAR;
    }
    for (;;) {
        const bool has_next = S.next(ui + 1, nxt);
        const char* nA = has_next ? (const char*)g.A + (size_t)nxt.pm * tstep : cA; const char* nB = has_next ? (const char*)g.Bt + (size_t)nxt.pn * tstep : cB;
        for (int t = 0; t < nt; t += 2) {
            const bool last = (t == nt - 2);
            const char* a1 = cA + (size_t)(t + 1) * kstep;
            const char* a2 = last ? nA : cA + (size_t)(t + 2) * kstep; const char* b2 = last ? nB : cB + (size_t)(t + 2) * kstep;
            const char* a3 = a2 + kstep; const char* b3 = b2 + kstep;
            if (last && has_next) S.a_ready(nxt);
            if constexpr (SP2) {
            PG8_LDB(B0, 0, 0); PG8_LDB(B1, 0, 1); PG8_SCHED; PG8_LDA(At, 0, 0); PG8_STAGE(PG8_SA(1, 1), a1 + hstep, voffA);
            PG8_WAIT_V(8); PG8_WAIT_L(0); PG8_BAR; PG8_MMA(0, 0, At, B0); PG8_MMA(0, 1, At, B1); PG8_BAR; PG8_SCHED;
            PG8_LDA(At, 0, 1); PG8_STAGE(PG8_SB(0, 0), b2, voffB); PG8_STAGE(PG8_SB(0, 1), b2 + hstep, voffB); PG8_STAGE(PG8_SA(0, 0), a2, voffA);
            PG8_WAIT_V(8); PG8_WAIT_L(0); PG8_BAR; PG8_MMA(1, 0, At, B0); PG8_MMA(1, 1, At, B1); PG8_BAR; PG8_SCHED;
            PG8_LDB(B0, 1, 0); PG8_LDB(B1, 1, 1); PG8_SCHED; PG8_LDA(At, 1, 0); PG8_STAGE(PG8_SA(0, 1), a2 + hstep, voffA);
            PG8_WAIT_V(8); PG8_WAIT_L(0); PG8_BAR; PG8_MMA(0, 0, At, B0); PG8_MMA(0, 1, At, B1); PG8_BAR; PG8_SCHED;
            PG8_LDA(At, 1, 1); PG8_STAGE(PG8_SB(1, 0), b3, voffB); PG8_STAGE(PG8_SB(1, 1), b3 + hstep, voffB); PG8_STAGE(PG8_SA(1, 0), a3, voffA);
            PG8_WAIT_V(8); PG8_WAIT_L(0); PG8_BAR; PG8_MMA(1, 0, At, B0); PG8_MMA(1, 1, At, B1); PG8_BAR; PG8_SCHED;
            } else {
            PG8_LDB(B0, 0, 0); PG8_SCHED; PG8_LDA(At, 0, 0); PG8_STAGE(PG8_SA(1, 1), a1 + hstep, voffA);
            PG8_WAIT_L(8); PG8_BAR; PG8_WAIT_L(0); PG8_MMA(0, 0, At, B0); PG8_BAR; PG8_SCHED;
            PG8_LDB(B1, 0, 1); PG8_STAGE(PG8_SB(0, 0), b2, voffB);
            PG8_BAR; PG8_WAIT_L(0); PG8_MMA(0, 1, At, B1); PG8_BAR;
            PG8_LDA(At, 0, 1); PG8_STAGE(PG8_SA(0, 0), a2, voffA);
            PG8_BAR; PG8_WAIT_L(0); PG8_MMA(1, 0, At, B0); PG8_BAR; PG8_SCHED;
            PG8_STAGE(PG8_SB(0, 1), b2 + hstep, voffB);
            PG8_WAIT_V(6); PG8_BAR; PG8_MMA(1, 1, At, B1); PG8_BAR;
            PG8_LDB(B0, 1, 0); PG8_SCHED; PG8_LDA(At, 1, 0); PG8_STAGE(PG8_SA(0, 1), a2 + hstep, voffA);
            PG8_WAIT_L(8); PG8_BAR; PG8_WAIT_L(0); PG8_MMA(0, 0, At, B0); PG8_BAR; PG8_SCHED;
            PG8_LDB(B1, 1, 1); PG8_STAGE(PG8_SB(1, 0), b3, voffB);
            PG8_BAR; PG8_WAIT_L(0); PG8_MMA(0, 1, At, B1); PG8_BAR;
            PG8_LDA(At, 1, 1); PG8_STAGE(PG8_SA(1, 0), a3, voffA);
            PG8_BAR; PG8_WAIT_L(0); PG8_MMA(1, 0, At, B0); PG8_BAR; PG8_SCHED;
            PG8_STAGE(PG8_SB(1, 1), b3 + hstep, voffB);
            PG8_WAIT_V(6); PG8_BAR; PG8_MMA(1, 1, At, B1); PG8_BAR;
            }
        }
        if constexpr (ALIGN_EPI) { if (wr == 0) PG8_BAR; }
        if constexpr (!Epi::AFTER_DRAIN) { E(acc, cur, wr, wc, fr, fq); S.done(cur); }
        if (!has_next) break;
#pragma unroll
        for (int a = 0; a < 2; ++a)
#pragma unroll
            for (int b = 0; b < 2; ++b)
#pragma unroll
                for (int m = 0; m < 4; ++m)
#pragma unroll
                    for (int n = 0; n < 2; ++n) acc[a][b][m][n] = (f32x4){0.f, 0.f, 0.f, 0.f};
        cur = nxt; cA = nA; cB = nB; ++ui;
        if constexpr (ALIGN_EPI) { if (wr == 1) PG8_BAR; }
    }
    PG8_WAIT_V(0);
    if constexpr (!ALIGN_EPI) { if (wr == 0) PG8_BAR; }
    PG8_BAR;
    if constexpr (Epi::AFTER_DRAIN) { E.fused(acc, cur, wr, wc, fr, fq, lds, wid, lane); S.done(cur); }
#undef PG8_SA
#undef PG8_SB
#undef PG8_STAGE
#undef PG8_LDA
#undef PG8_LDB
#undef PG8_MMA
#undef PG8_WAIT_V
#undef PG8_WAIT_L
#undef PG8_BAR
#undef PG8_SCHED
}
}

#ifndef PG8_SP2
#define PG8_SP2 true
#endif
#ifndef PG8_ALIGN
#define PG8_ALIGN true
#endif
#ifndef MK_N_LAUNCHES
#define MK_N_LAUNCHES 1
#endif
constexpr int NWAVES = 8;
constexpr int N_PHASES = 9;
constexpr int N_LAUNCHES = MK_N_LAUNCHES;
constexpr int DM = 1024, FF = 2816, NGU = 2 * FF, DIN = 1792;
constexpr int MP = 16384, MS = 512, M = MP + MS;
constexpr int ZQ = 0, ZK = 512, ZV = 640, ZU = 768, ZG = 1280;
constexpr float EPS = 1e-6f, LOG2E_F = 1.4426950408889634f;
constexpr size_t O_Y = 0, O_KP = 17301504, O_VP = 17367040, O_KS = 17432576, O_VS = 19529728, O_GP = 21626880, O_GS = 21889024, O_END = 22151168;
constexpr size_t MiB = 1u << 20;
constexpr size_t WS_CTL = 0, CTL_ZERO_BYTES = 1 * MiB;
constexpr size_t WS_WGU1 = 1 * MiB, WS_WD1 = 12 * MiB, WS_WIN = 18 * MiB, WS_WOUT = 22 * MiB, WS_WGU2 = 24 * MiB, WS_WD2 = 35 * MiB;
constexpr size_t WS_TRIL = 41 * MiB, WS_ROPE = 42 * MiB, WS_SS1 = 44 * MiB, WS_SS2 = 46 * MiB, WS_SS3 = 48 * MiB, WS_SSV = 50 * MiB;
constexpr size_t WS_XB = 52 * MiB;
constexpr size_t WS_H = 86 * MiB;
constexpr size_t WS_Z = WS_H, WS_AO = WS_H + (size_t)M * DIN * 2;
constexpr size_t WS_END = WS_H + (size_t)M * FF * 2;
static_assert(WS_AO + (size_t)M * DM * 2 <= WS_END && WS_END <= 256 * MiB && WS_XB + (size_t)M * DM * 2 <= WS_H, "d_ws map");
static_assert(WS_WGU1 + (size_t)NGU * DM * 2 <= WS_WD1 && WS_WD1 + (size_t)DM * FF * 2 <= WS_WIN && WS_WIN + (size_t)DIN * DM * 2 <= WS_WOUT && WS_WGU2 + (size_t)NGU * DM * 2 <= WS_WD2 && WS_WD2 + (size_t)DM * FF * 2 <= WS_TRIL, "weights map");
static_assert(WS_ROPE + 4100 * 64 * 4 <= WS_SS1 && WS_SS1 + (size_t)M * 64 <= WS_SS2 && WS_SSV + (size_t)M * 32 <= WS_XB, "small tables map");
constexpr int CW_TMO = 0, CW_CODE = 1, CW_BAR = 4096;
constexpr int RING_OFF = 0, PHASE_BYTES = 139264;
constexpr int XCH_OFF = 135168;
constexpr int LDSCTL_OFF = PHASE_BYTES, MISC_OFF = LDSCTL_OFF + 320;
constexpr int LDS_BYTES = 147456;
static_assert(MISC_OFF + 128 <= LDS_BYTES && XCH_OFF + 4096 <= PHASE_BYTES, "LDS map");

#define GAS __attribute__((address_space(1)))
#define LAS __attribute__((address_space(3)))
typedef unsigned short bf16;
typedef unsigned v4u __attribute__((ext_vector_type(4)));
typedef unsigned v2u __attribute__((ext_vector_type(2)));
typedef float f32x4 __attribute__((ext_vector_type(4)));
typedef short bf16x8 __attribute__((ext_vector_type(8)));
typedef short s16x4 __attribute__((ext_vector_type(4)));
typedef GAS unsigned gu32;
typedef GAS unsigned long long gu64;
#define RLX_AGENT __ATOMIC_RELAXED, __HIP_MEMORY_SCOPE_AGENT
#define LDS_WAIT() asm volatile("s_waitcnt lgkmcnt(0)" ::: "memory")
#define VM_WAIT() asm volatile("s_waitcnt vmcnt(0)" ::: "memory")
__device__ __forceinline__ unsigned f2bf(float f) { unsigned u = __builtin_bit_cast(unsigned, f); return (u + 0x7fffu + ((u >> 16) & 1u)) >> 16; }
__device__ __forceinline__ unsigned pk2(float lo, float hi) { return f2bf(lo) | (f2bf(hi) << 16); }
__device__ __forceinline__ float bf_lo(unsigned w) { return __builtin_bit_cast(float, w << 16); }
__device__ __forceinline__ float bf_hi(unsigned w) { return __builtin_bit_cast(float, w & 0xffff0000u); }
__device__ __forceinline__ float xs4(float s) { s += __shfl_xor(s, 16); s += __shfl_xor(s, 32); return s; }
__device__ __forceinline__ float wave_sum(float v) {
#pragma unroll
    for (int o = 1; o < 64; o <<= 1) v += __shfl_xor(v, o);
    return v;
}
#define XB_TMO      128
#define XB_XCNT(j)  (256  + 64 * (j))
#define XB_XSUB(j)  (1280 + 64 * (j))
#define XB_XGEN(j)  (2304 + 64 * (j))
#define XB_TOP      3328
#define XB_TOPGEN   3392
#define XCD_BAR_WORDS 3456
#define XB_SPIN_CAP (1u << 18)

__device__ __forceinline__ unsigned xb_ld(unsigned* p)              { return __hip_atomic_load(p, __ATOMIC_RELAXED, __HIP_MEMORY_SCOPE_AGENT); }
__device__ __forceinline__ unsigned xb_add(unsigned* p, unsigned v) { return __hip_atomic_fetch_add(p, v, __ATOMIC_RELAXED, __HIP_MEMORY_SCOPE_AGENT); }
__device__ __forceinline__ unsigned xb_xcc_id() { return (unsigned)__builtin_amdgcn_s_getreg((3 << 11) | 20) & 0xFu; }
#define XB_SPIN(cond, bar) do { unsigned _sp = 0; while (cond) { __builtin_amdgcn_s_sleep(1); \
    if ((++_sp & 255u) == 0u) { if (xb_ld(&(bar)[XB_TMO])) break; if (_sp > XB_SPIN_CAP) { atomicAdd(&(bar)[XB_TMO], 1u); break; } } } } while (0)

struct XcdBarrier {
    unsigned* bar; unsigned x;
    volatile LAS unsigned* st;
};

__device__ __forceinline__ XcdBarrier xcd_barrier_post(unsigned* bar, volatile LAS unsigned* st) {
    XcdBarrier b; b.bar = bar; b.x = xb_xcc_id(); b.st = st;
    if (threadIdx.x == 0) (void)xb_add(&bar[XB_XCNT(b.x)], 1u);
    return b;
}
__device__ __forceinline__ void xcd_barrier_complete(unsigned* bar, unsigned x, unsigned& nloc, unsigned& nx) {
    const unsigned G = gridDim.x * gridDim.y * gridDim.z;
    unsigned sum, cnt, mine, sp = 0u;
    for (;;) {
        sum = 0u; cnt = 0u; mine = 0u;
#pragma unroll
        for (unsigned j = 0; j < 16; ++j) { const unsigned c = xb_ld(&bar[XB_XCNT(j)]); sum += c; cnt += (c > 0u) ? 1u : 0u; mine = (j == x) ? c : mine; }
        if (sum == G) break;
        __builtin_amdgcn_s_sleep(1);
        if ((++sp & 255u) == 0u) { if (xb_ld(&bar[XB_TMO])) break; if (sp > XB_SPIN_CAP) { atomicAdd(&bar[XB_TMO], 1u); break; } }
    }
    nloc = mine > 0u ? mine : 1u; nx = cnt > 0u ? cnt : 1u;
}

__device__ __forceinline__ void xcd_barrier(const XcdBarrier& b) {
    asm volatile("s_waitcnt vmcnt(0)" ::: "memory");
    __syncthreads();
    if (threadIdx.x == 0) {
        unsigned* bar = b.bar;
        __builtin_amdgcn_s_waitcnt(0);
        unsigned nloc = b.st[0], nx = b.st[1];
        if (nloc == 0u) { xcd_barrier_complete(bar, b.x, nloc, nx); b.st[0] = nloc; b.st[1] = nx; }
        const unsigned old = xb_add(&bar[XB_XSUB(b.x)], 1u);
        const unsigned gen = old / nloc;
        if (old + 1u == (gen + 1u) * nloc) {
            __builtin_amdgcn_fence(__ATOMIC_RELEASE, "agent");
            asm volatile("s_waitcnt vmcnt(0)" ::: "memory");
            const unsigned og = xb_add(&bar[XB_TOP], 1u);
            const unsigned tg = og / nx;
            if (og + 1u == (tg + 1u) * nx) xb_add(&bar[XB_TOPGEN], 1u);
            else XB_SPIN(xb_ld(&bar[XB_TOPGEN]) == tg, bar);
            __builtin_amdgcn_fence(__ATOMIC_ACQUIRE, "agent");
            xb_add(&bar[XB_XGEN(b.x)], 1u);
            asm volatile("s_waitcnt vmcnt(0)" ::: "memory");
        } else {
            XB_SPIN(xb_ld(&bar[XB_XGEN(b.x)]) == gen, bar);
            __builtin_amdgcn_fence(__ATOMIC_ACQUIRE, "agent");
            asm volatile("s_waitcnt vmcnt(0)" ::: "memory");
        }
    }
    __syncthreads();
}


struct Frame {
    LAS unsigned char* lds;
    volatile LAS unsigned* MISC;
    gu32* ctl;
    int tid, lane, wave;
    int vcu, G;
    const float* in[22]; float* out; unsigned char* ws;
};
__constant__ float c_inv_freq[32] = {
    1.000000000e+00f, 7.498942018e-01f, 5.623413324e-01f, 4.216965139e-01f, 3.162277639e-01f, 2.371373773e-01f, 1.778279394e-01f, 1.333521456e-01f,
    1.000000015e-01f, 7.498942316e-02f, 5.623413250e-02f, 4.216964915e-02f, 3.162277490e-02f, 2.371373773e-02f, 1.778279431e-02f, 1.333521400e-02f,
    9.999999776e-03f, 7.498942316e-03f, 5.623413250e-03f, 4.216964822e-03f, 3.162277630e-03f, 2.371373819e-03f, 1.778279431e-03f, 1.333521446e-03f,
    1.000000047e-03f, 7.498941850e-04f, 5.623413017e-04f, 4.216965172e-04f, 3.162277571e-04f, 2.371373703e-04f, 1.778279402e-04f, 1.333521504e-04f };

__device__ __forceinline__ void p0_transpose_item(const float* W, int K, int N, bf16* WT, int mode, const float* gk, LAS float* scr, int item, int lane) {
    const int nblk = N / 32, kb = item / nblk, nb = item % nblk, k0 = 64 * kb, n0 = 32 * nb;
    int rb = n0;
    if (mode == 1) rb = 256 * (n0 >> 7) + (n0 & 127);
    else if (mode == 2) rb = 256 * (n0 >> 7) + 128 + (n0 & 127);
    else if (mode == 3) rb = (n0 & ~0xE0) | (((n0 >> 5) & 1) << 7) | (((n0 >> 6) & 3) << 5);
#pragma unroll 8
    for (int i = 0; i < 32; ++i) { const int kk = 2 * i + (lane >> 5); scr[kk * 33 + (lane & 31)] = W[(size_t)(k0 + kk) * N + n0 + (lane & 31)]; }
    LDS_WAIT(); asm volatile("" ::: "memory");
    const int c = lane & 7;
    float g8[8];
#pragma unroll
    for (int e = 0; e < 8; ++e) g8[e] = gk ? gk[k0 + 8 * c + e] : 1.0f;
#pragma unroll
    for (int j = 0; j < 4; ++j) { const int n = (lane >> 3) + 8 * j; const LAS float* s = scr + (8 * c) * 33 + n;
        v4u o; o.x = pk2(s[0 * 33] * g8[0], s[1 * 33] * g8[1]); o.y = pk2(s[2 * 33] * g8[2], s[3 * 33] * g8[3]); o.z = pk2(s[4 * 33] * g8[4], s[5 * 33] * g8[5]); o.w = pk2(s[6 * 33] * g8[6], s[7 * 33] * g8[7]);
        *(GAS v4u*)(WT + (size_t)(rb + n) * K + k0 + 8 * c) = o; }
    LDS_WAIT(); asm volatile("" ::: "memory");
}
__device__ __forceinline__ void rms_row_to_bf16(int lane, const float* xrow, const float* gain, bf16* orow) {
    const GAS f32x4* xr = (const GAS f32x4*)xrow + lane; const GAS f32x4* gr = (const GAS f32x4*)gain + lane;
    f32x4 v[4]; float s = 0.f;
#pragma unroll
    for (int j = 0; j < 4; ++j) { v[j] = xr[64 * j]; s += (v[j].x * v[j].x + v[j].y * v[j].y) + (v[j].z * v[j].z + v[j].w * v[j].w); }
    const float rs = 1.0f / sqrtf(wave_sum(s) * (1.f / DM) + EPS);
    GAS unsigned long long* o8 = (GAS unsigned long long*)orow + lane;
#pragma unroll
    for (int j = 0; j < 4; ++j) { const f32x4 g = gr[64 * j]; o8[64 * j] = (unsigned long long)pk2(v[j].x * rs * g.x, v[j].y * rs * g.y) | ((unsigned long long)pk2(v[j].z * rs * g.z, v[j].w * rs * g.w) << 32); }
}
__device__ __forceinline__ void sincos_d(float ang, float& sn, float& cs) {
    const double x = (double)ang; const double kd = __builtin_rint(x * 0.63661977236758134308);
    const double r = __builtin_fma(-kd, 6.123233995736766036e-17, __builtin_fma(-kd, 1.5707963267948966192, x)); const double r2 = r * r;
    double ps = -7.6471637318198164759e-13; ps = ps * r2 + 1.6059043836821614599e-10; ps = ps * r2 - 2.5052108385441718775e-08; ps = ps * r2 + 2.7557319223985890653e-06; ps = ps * r2 - 1.9841269841269841270e-04;
    ps = ps * r2 + 8.3333333333333333333e-03; ps = ps * r2 - 1.6666666666666666667e-01; const double s = r + r * r2 * ps;
    double pc = 4.7794773323873852974e-14; pc = pc * r2 - 1.1470745597729724714e-11; pc = pc * r2 + 2.0876756987868098979e-09; pc = pc * r2 - 2.7557319223985890653e-07; pc = pc * r2 + 2.4801587301587301587e-05;
    pc = pc * r2 - 1.3888888888888888889e-03; pc = pc * r2 + 4.1666666666666666667e-02; pc = pc * r2 - 0.5; const double c = 1.0 + r2 * pc;
    const int q = (int)kd & 3;
    const double ss = (q & 1) ? c : s, cc = (q & 1) ? s : c;
    sn = (float)((q & 2) ? -ss : ss); cs = (float)(((q + 1) & 2) ? -cc : cc);
}
__device__ __forceinline__ void p0_prologue(Frame& F) {
    LAS float* scr = (LAS float*)(F.lds + RING_OFF + F.wave * 16384);
    const int gw = F.vcu * NWAVES + F.wave, NGW = F.G * NWAVES;
    bf16* Wgu1 = (bf16*)(F.ws + WS_WGU1); bf16* Wd1 = (bf16*)(F.ws + WS_WD1); bf16* Win = (bf16*)(F.ws + WS_WIN); bf16* Wout = (bf16*)(F.ws + WS_WOUT); bf16* Wgu2 = (bf16*)(F.ws + WS_WGU2); bf16* Wd2 = (bf16*)(F.ws + WS_WD2);
    constexpr int I_GU = (DM / 64) * (FF / 32), I_D = (FF / 64) * (DM / 32), I_IN = (DM / 64) * (DIN / 32), I_OUT = (DM / 64) * (DM / 32);
    constexpr int NITEMS = 4 * I_GU + 2 * I_D + I_IN + I_OUT;
    for (int it = gw; it < NITEMS; it += NGW) {
        int r = it;
        if (r < I_GU) { p0_transpose_item(F.in[5], DM, FF, Wgu1, 1, nullptr, scr, r, F.lane); continue; } r -= I_GU;
        if (r < I_GU) { p0_transpose_item(F.in[6], DM, FF, Wgu1, 2, nullptr, scr, r, F.lane); continue; } r -= I_GU;
        if (r < I_D) { p0_transpose_item(F.in[7], FF, DM, Wd1, 0, nullptr, scr, r, F.lane); continue; } r -= I_D;
        if (r < I_IN) { p0_transpose_item(F.in[9], DM, DIN, Win, 3, F.in[8], scr, r, F.lane); continue; } r -= I_IN;
        if (r < I_OUT) { p0_transpose_item(F.in[16], DM, DM, Wout, 0, nullptr, scr, r, F.lane); continue; } r -= I_OUT;
        if (r < I_GU) { p0_transpose_item(F.in[18], DM, FF, Wgu2, 1, F.in[17], scr, r, F.lane); continue; } r -= I_GU;
        if (r < I_GU) { p0_transpose_item(F.in[19], DM, FF, Wgu2, 2, F.in[17], scr, r, F.lane); continue; } r -= I_GU;
        p0_transpose_item(F.in[20], FF, DM, Wd2, 0, nullptr, scr, r, F.lane);
    }
    bf16* XB = (bf16*)(F.ws + WS_XB);
    for (int m = gw; m < M; m += NGW) { const float* xr = (m < MP) ? F.in[0] + (size_t)m * DM : F.in[1] + (size_t)(m - MP) * DM; rms_row_to_bf16(F.lane, xr, F.in[4], XB + (size_t)m * DM); }
    float* rope = (float*)(F.ws + WS_ROPE);
    const int gt = F.vcu * (NWAVES * 64) + F.tid, NGT = F.G * NWAVES * 64;
    for (int e = gt; e < 4100 * 32; e += NGT) { const int pi = e >> 5, i = e & 31; const int pos = pi < 4096 ? pi : 16384 + (pi - 4096);
        const float ang = (float)pos * c_inv_freq[i]; float sn, cs; sincos_d(ang, sn, cs); rope[pi * 64 + i] = cs; rope[pi * 64 + 32 + i] = sn; }
    bf16* tril = (bf16*)(F.ws + WS_TRIL);
    for (int e = gt; e < 8 * 128 * 128; e += NGT) { const int s = e & 127, t = (e >> 7) & 127; tril[e] = (bf16)f2bf(s <= t ? F.in[12][e] : 0.f); }
}

constexpr int KVS = 160;
constexpr int GVS = 1056;
typedef short v4i16_t __attribute__((ext_vector_type(4)));
__device__ __forceinline__ s16x4 vtr(LAS const unsigned char* p) { return __builtin_bit_cast(s16x4, __builtin_amdgcn_ds_read_tr16_b64_v4i16((LAS v4i16_t*)p)); }
__device__ __forceinline__ unsigned cvtpk(float lo, float hi) { unsigned r; asm volatile("v_cvt_pk_bf16_f32 %0, %1, %2" : "=v"(r) : "v"(lo), "v"(hi)); return r; }
#define MFMA16(a, b, c) __builtin_amdgcn_mfma_f32_16x16x32_bf16((a), (b), (c), 0, 0, 0)
template <int NF> __device__ __forceinline__ void attn_core(f32x4 (&o)[4], bf16x8 qf0, bf16x8 qf1, LAS const unsigned char* kp, LAS const unsigned char* vp, int slot0, int slot_lo, int slot_hi, float sink2) {
    f32x4 s[NF];
#pragma unroll
    for (int f = 0; f < NF; ++f) { const bf16x8 k0 = *(const LAS bf16x8*)(kp + f * 16 * KVS), k1 = *(const LAS bf16x8*)(kp + f * 16 * KVS + 64);
        s[f] = MFMA16(k0, qf0, ((f32x4){0.f, 0.f, 0.f, 0.f})); s[f] = MFMA16(k1, qf1, s[f]); }
    float mx = sink2;
#pragma unroll
    for (int f = 0; f < NF; ++f)
#pragma unroll
        for (int r = 0; r < 4; ++r) { const int slot = slot0 + 16 * f + r; const float v = (slot >= slot_lo && slot <= slot_hi) ? s[f][r] : -INFINITY; s[f][r] = v; mx = fmaxf(mx, v); }
    mx = fmaxf(mx, __shfl_xor(mx, 16)); mx = fmaxf(mx, __shfl_xor(mx, 32));
    float l = 0.f;
#pragma unroll
    for (int f = 0; f < NF; ++f)
#pragma unroll
        for (int r = 0; r < 4; ++r) { const float p = __builtin_amdgcn_exp2f(s[f][r] - mx); s[f][r] = p; l += p; }
    l = xs4(l) + __builtin_amdgcn_exp2f(sink2 - mx);
#pragma unroll
    for (int d0 = 0; d0 < 4; ++d0) o[d0] = (f32x4){0.f, 0.f, 0.f, 0.f};
#pragma unroll
    for (int kk = 0; kk < (NF + 1) / 2; ++kk) { const int f0 = 2 * kk, f1 = (2 * kk + 1 < NF) ? 2 * kk + 1 : f0; const bool two = (2 * kk + 1 < NF);
        v4u pw; pw.x = cvtpk(s[f0][0], s[f0][1]); pw.y = cvtpk(s[f0][2], s[f0][3]); pw.z = two ? cvtpk(s[f1][0], s[f1][1]) : 0u; pw.w = two ? cvtpk(s[f1][2], s[f1][3]) : 0u;
        const bf16x8 pb = __builtin_bit_cast(bf16x8, pw);
#pragma unroll
        for (int d0 = 0; d0 < 4; ++d0) { const s16x4 lo = vtr(vp + f0 * 16 * KVS + d0 * 32), hi = vtr(vp + f1 * 16 * KVS + d0 * 32);
            const bf16x8 va = (bf16x8){lo[0], lo[1], lo[2], lo[3], hi[0], hi[1], hi[2], hi[3]};
            o[d0] = MFMA16(va, pb, o[d0]); } }
    const float inv = 1.0f / l;
#pragma unroll
    for (int d0 = 0; d0 < 4; ++d0) o[d0] = o[d0] * inv;
}

__device__ __forceinline__ void p4_attn_unit(Frame& F, int b, int j) {
    const bf16* Z = (const bf16*)(F.ws + WS_Z); bf16* AO = (bf16*)(F.ws + WS_AO);
    LAS unsigned char* Kl = F.lds; LAS unsigned char* Vl = F.lds + 2 * 192 * KVS; LAS float* xch = (LAS float*)(F.lds + XCH_OFF);
    const int lane = F.lane, w = F.wave, g = lane >> 4, ql = lane & 15;
    const int kb0 = 64 * j - 128;
    for (int i = F.tid; i < 192 * 32; i += NWAVES * 64) { const int slot = i >> 5, within = i & 31, pos = kb0 + slot;
        v4u v = (v4u){0u, 0u, 0u, 0u};
        if (pos >= 0) v = *(const GAS v4u*)(Z + (size_t)(b * 4096 + pos) * DIN + ZK + within * 8);
        LAS unsigned char* dst = ((within & 16) ? Vl : Kl) + ((within >> 3) & 1) * (192 * KVS) + slot * KVS + (within & 7) * 16;
        *(LAS v4u*)dst = v; }
    __syncthreads();
    const int kvh = w >> 2; const float sink2 = F.in[10][w] * LOG2E_F;
    LAS const unsigned char* Kb = Kl + kvh * (192 * KVS); LAS const unsigned char* Vb = Vl + kvh * (192 * KVS);
    const int smin = (kb0 < 0) ? -kb0 : 0;
    f32x4 o[4][4];
#pragma unroll
    for (int qf = 0; qf < 4; ++qf) {
        const size_t m = (size_t)b * 4096 + 64 * j + 16 * qf + ql;
        const bf16x8 qf0 = *(const GAS bf16x8*)(Z + m * DIN + ZQ + w * 64 + 8 * g), qf1 = *(const GAS bf16x8*)(Z + m * DIN + ZQ + w * 64 + 32 + 8 * g);
        const int lo = 16 * qf + ql + 1;
        attn_core<9>(o[qf], qf0, qf1, Kb + (16 * qf + ql) * KVS + 16 * g, Vb + (16 * qf + 4 * g + (ql >> 2)) * KVS + 8 * (ql & 3), 16 * qf + 4 * g, lo > smin ? lo : smin, 16 * qf + ql + 128, sink2);
        float q = 0.f;
#pragma unroll
        for (int d0 = 0; d0 < 4; ++d0) q += (o[qf][d0][0] * o[qf][d0][0] + o[qf][d0][1] * o[qf][d0][1]) + (o[qf][d0][2] * o[qf][d0][2] + o[qf][d0][3] * o[qf][d0][3]);
        q = xs4(q);
        if (g == 0) xch[(16 * qf + ql) * 8 + w] = q;
    }
    __syncthreads();
    const float* ga = F.in[14];
#pragma unroll
    for (int qf = 0; qf < 4; ++qf) {
        const f32x4 t0 = *(const LAS f32x4*)(xch + (16 * qf + ql) * 8), t1 = *(const LAS f32x4*)(xch + (16 * qf + ql) * 8 + 4);
        const float tot = ((t0[0] + t0[1]) + (t0[2] + t0[3])) + ((t1[0] + t1[1]) + (t1[2] + t1[3]));
        const float ra = 1.0f / sqrtf(tot * (1.0f / 512.0f) + EPS);
        const size_t m = (size_t)b * 4096 + 64 * j + 16 * qf + ql;
#pragma unroll
        for (int d0 = 0; d0 < 4; ++d0) { const int col = w * 64 + 16 * d0 + 4 * g; const f32x4 gn = *(const GAS f32x4*)(ga + col); const f32x4 v = o[qf][d0] * ra * gn;
            v2u pk; pk.x = cvtpk(v[0], v[1]); pk.y = cvtpk(v[2], v[3]); *(GAS v2u*)(AO + m * DM + col) = pk; }
    }
    __syncthreads();
}

__device__ __forceinline__ void p4_gmlp_unit(Frame& F, int b, int hc) {
    const bf16* Z = (const bf16*)(F.ws + WS_Z); bf16* AO = (bf16*)(F.ws + WS_AO); const float* ssv = (const float*)(F.ws + WS_SSV); const bf16* tril = (const bf16*)(F.ws + WS_TRIL);
    LAS unsigned char* Gl = F.lds; LAS float* xch = (LAS float*)(F.lds + XCH_OFF);
    const int lane = F.lane, w = F.wave, g = lane >> 4, ql = lane & 15;
    const int n = hc >> 1, half = hc & 1, ns = 64 * (half + 1); const size_t m0 = (size_t)b * 4096 + 128 * n;
    {
        const int cc = F.tid & 63; const f32x4 gv0 = *(const GAS f32x4*)(F.in[11] + 8 * cc), gv1 = *(const GAS f32x4*)(F.in[11] + 8 * cc + 4);
        const bool wout = (n == 31 && half == 1); float* ogp = F.out + O_GP;
        for (int sr = w; sr < ns; sr += NWAVES) { const size_t m = m0 + sr;
            const f32x4 p0 = *(const GAS f32x4*)(ssv + m * 8), p1 = *(const GAS f32x4*)(ssv + m * 8 + 4);
            const float rs = 1.0f / sqrtf((((p0[0] + p0[1]) + (p0[2] + p0[3])) + ((p1[0] + p1[1]) + (p1[2] + p1[3]))) * (1.0f / 512.0f) + EPS);
            const v4u raw = *(const GAS v4u*)(Z + m * DIN + ZG + 8 * cc);
            const f32x4 a = (f32x4){bf_lo(raw.x), bf_hi(raw.x), bf_lo(raw.y), bf_hi(raw.y)} * rs * gv0, c = (f32x4){bf_lo(raw.z), bf_hi(raw.z), bf_lo(raw.w), bf_hi(raw.w)} * rs * gv1;
            v4u pk; pk.x = cvtpk(a[0], a[1]); pk.y = cvtpk(a[2], a[3]); pk.z = cvtpk(c[0], c[1]); pk.w = cvtpk(c[2], c[3]);
            *(LAS v4u*)(Gl + sr * GVS + cc * 16) = pk;
            if (wout) { float* op = ogp + ((size_t)b * 128 + sr) * 512 + 8 * cc; *(GAS f32x4*)op = a; *(GAS f32x4*)(op + 4) = c; } }
    }
    __syncthreads();
    f32x4 y[4][4];
#pragma unroll
    for (int tf = 0; tf < 4; ++tf) {
        const int tc = 64 * half + 16 * tf + ql; const size_t mt = m0 + tc;
        const int nfr = 4 * half + tf + 1, npair = (nfr + 1) >> 1;
        f32x4 acc[4];
#pragma unroll
        for (int d0 = 0; d0 < 4; ++d0) acc[d0] = (f32x4){0.f, 0.f, 0.f, 0.f};
        const bf16* wrow = tril + ((size_t)w * 128 + tc) * 128 + 4 * g;
        LAS const unsigned char* gp = Gl + (4 * g + (ql >> 2)) * GVS + (w * 64 + 4 * (ql & 3)) * 2;
        for (int kk = 0; kk < npair; ++kk) { const int f0 = 2 * kk; const bool two = (2 * kk + 1 < nfr); const int f1 = two ? f0 + 1 : f0;
            v2u w0 = *(const GAS v2u*)(wrow + 16 * f0), w1 = *(const GAS v2u*)(wrow + 16 * f1); if (!two) w1 = (v2u){0u, 0u};
            const bf16x8 pb = __builtin_bit_cast(bf16x8, ((v4u){w0.x, w0.y, w1.x, w1.y}));
#pragma unroll
            for (int d0 = 0; d0 < 4; ++d0) { const s16x4 lo = vtr(gp + f0 * 16 * GVS + d0 * 32), hi = vtr(gp + f1 * 16 * GVS + d0 * 32);
                const bf16x8 va = (bf16x8){lo[0], lo[1], lo[2], lo[3], hi[0], hi[1], hi[2], hi[3]};
                acc[d0] = MFMA16(va, pb, acc[d0]); } }
        const float bias = F.in[13][w * 128 + tc]; float q = 0.f;
#pragma unroll
        for (int d0 = 0; d0 < 4; ++d0) { const v2u ur = *(const GAS v2u*)(Z + mt * DIN + ZU + w * 64 + 16 * d0 + 4 * g);
            const f32x4 uu = (f32x4){bf_lo(ur.x), bf_hi(ur.x), bf_lo(ur.y), bf_hi(ur.y)}; const f32x4 v = uu * (acc[d0] + bias); y[tf][d0] = v;
            q += (v[0] * v[0] + v[1] * v[1]) + (v[2] * v[2] + v[3] * v[3]); }
        q = xs4(q);
        if (g == 0) xch[(16 * tf + ql) * 8 + w] = q;
    }
    __syncthreads();
    const float* gg = F.in[15];
#pragma unroll
    for (int tf = 0; tf < 4; ++tf) {
        const f32x4 t0 = *(const LAS f32x4*)(xch + (16 * tf + ql) * 8), t1 = *(const LAS f32x4*)(xch + (16 * tf + ql) * 8 + 4);
        const float tot = ((t0[0] + t0[1]) + (t0[2] + t0[3])) + ((t1[0] + t1[1]) + (t1[2] + t1[3]));
        const float rg = 1.0f / sqrtf(tot * (1.0f / 512.0f) + EPS);
        const size_t mt = m0 + 64 * half + 16 * tf + ql;
#pragma unroll
        for (int d0 = 0; d0 < 4; ++d0) { const int col = w * 64 + 16 * d0 + 4 * g; const f32x4 gn = *(const GAS f32x4*)(gg + col); const f32x4 v = y[tf][d0] * rg * gn;
            v2u pk; pk.x = cvtpk(v[0], v[1]); pk.y = cvtpk(v[2], v[3]); *(GAS v2u*)(AO + mt * DM + 512 + col) = pk; }
    }
    __syncthreads();
}

__device__ __forceinline__ void p4_sample_unit(Frame& F, int b) {
    const bf16* Z = (const bf16*)(F.ws + WS_Z); bf16* AO = (bf16*)(F.ws + WS_AO); const float* ssv = (const float*)(F.ws + WS_SSV);
    LAS unsigned char* Kl = F.lds; LAS unsigned char* Vl = F.lds + 2 * 144 * KVS; LAS float* xch = (LAS float*)(F.lds + XCH_OFF); LAS float* xch2 = xch + 512;
    const int lane = F.lane, w = F.wave, g = lane >> 4, ql = lane & 15, tid = F.tid;
    const float* ck = F.in[2] + (size_t)b * 128 * 128; const float* cv = F.in[3] + (size_t)b * 128 * 128;
    float* oks = F.out + O_KS + (size_t)b * 128 * 128; float* ovs = F.out + O_VS + (size_t)b * 128 * 128;
    for (int i = tid; i < 128 * 32; i += NWAVES * 64) { const int jr = i >> 5, c = i & 31, kvh = c >> 4, d4 = (c & 15) * 4;
        const f32x4 vk = *(const GAS f32x4*)(ck + jr * 128 + c * 4), vv = *(const GAS f32x4*)(cv + jr * 128 + c * 4);
        v2u pk; pk.x = cvtpk(vk[0], vk[1]); pk.y = cvtpk(vk[2], vk[3]); *(LAS v2u*)(Kl + kvh * (144 * KVS) + jr * KVS + d4 * 2) = pk;
        v2u pv; pv.x = cvtpk(vv[0], vv[1]); pv.y = cvtpk(vv[2], vv[3]); *(LAS v2u*)(Vl + kvh * (144 * KVS) + jr * KVS + d4 * 2) = pv;
        if (jr >= 4) { *(GAS f32x4*)(oks + (jr - 4) * 128 + c * 4) = vk; *(GAS f32x4*)(ovs + (jr - 4) * 128 + c * 4) = vv; } }
    if (tid < 128) { const int t = tid >> 5, within = tid & 31;
        const v4u v = *(const GAS v4u*)(Z + (size_t)(MP + 4 * b + t) * DIN + ZK + within * 8);
        LAS unsigned char* dst = ((within & 16) ? Vl : Kl) + ((within >> 3) & 1) * (144 * KVS) + (128 + t) * KVS + (within & 7) * 16; *(LAS v4u*)dst = v; }
    else if (tid < 128 + 384) { const int e = tid - 128, r = e >> 5, within = e & 31;
        LAS unsigned char* dst = ((within & 16) ? Vl : Kl) + ((within >> 3) & 1) * (144 * KVS) + (132 + r) * KVS + (within & 7) * 16; *(LAS v4u*)dst = (v4u){0u, 0u, 0u, 0u}; }
    __syncthreads();
    f32x4 o[4]; const int t_q = ql & 3, hq = ql >> 2;
    if (w < 2) {
        const int h = 4 * w + hq; const size_t m = (size_t)MP + 4 * b + t_q; const float sink2 = F.in[10][h] * LOG2E_F;
        const bf16x8 qf0 = *(const GAS bf16x8*)(Z + m * DIN + ZQ + h * 64 + 8 * g), qf1 = *(const GAS bf16x8*)(Z + m * DIN + ZQ + h * 64 + 32 + 8 * g);
        attn_core<9>(o, qf0, qf1, Kl + w * (144 * KVS) + ql * KVS + 16 * g, Vl + w * (144 * KVS) + (4 * g + (ql >> 2)) * KVS + 8 * (ql & 3), 4 * g, t_q + 1, t_q + 128, sink2);
        float q = 0.f;
#pragma unroll
        for (int d0 = 0; d0 < 4; ++d0) q += (o[d0][0] * o[d0][0] + o[d0][1] * o[d0][1]) + (o[d0][2] * o[d0][2] + o[d0][3] * o[d0][3]);
        q = xs4(q); q += __shfl_xor(q, 4); q += __shfl_xor(q, 8);
        if (lane < 4) xch[lane * 8 + w] = q;
    }
    const int c = tid; float gvn[4], yg[4];
    {
        const float gvc = F.in[11][c]; float* ogs = F.out + O_GS + (size_t)b * 4 * 512;
#pragma unroll
        for (int s = 0; s < 4; ++s) { const size_t m = (size_t)MP + 4 * b + s;
            const f32x4 p0 = *(const GAS f32x4*)(ssv + m * 8), p1 = *(const GAS f32x4*)(ssv + m * 8 + 4);
            const float rs = 1.0f / sqrtf((((p0[0] + p0[1]) + (p0[2] + p0[3])) + ((p1[0] + p1[1]) + (p1[2] + p1[3]))) * (1.0f / 512.0f) + EPS);
            const float raw = __builtin_bit_cast(float, (unsigned)Z[m * DIN + ZG + c] << 16); gvn[s] = raw * rs * gvc; ogs[s * 512 + c] = gvn[s]; }
#pragma unroll
        for (int t = 0; t < 4; ++t) { const size_t m = (size_t)MP + 4 * b + t; float mix = F.in[13][w * 128 + t];
#pragma unroll
            for (int s = 0; s <= t; ++s) mix += F.in[12][((size_t)w * 128 + t) * 128 + s] * gvn[s];
            const float uu = __builtin_bit_cast(float, (unsigned)Z[m * DIN + ZU + c] << 16); yg[t] = uu * mix;
            const float q = wave_sum(yg[t] * yg[t]); if (lane == 0) xch2[t * 8 + w] = q; }
    }
    __syncthreads();
    if (w < 2) {
        const int h = 4 * w + hq; const size_t m = (size_t)MP + 4 * b + t_q;
        const float tot = xch[t_q * 8] + xch[t_q * 8 + 1]; const float ra = 1.0f / sqrtf(tot * (1.0f / 512.0f) + EPS);
#pragma unroll
        for (int d0 = 0; d0 < 4; ++d0) { const int col = h * 64 + 16 * d0 + 4 * g; const f32x4 gn = *(const GAS f32x4*)(F.in[14] + col); const f32x4 v = o[d0] * ra * gn;
            v2u pk; pk.x = cvtpk(v[0], v[1]); pk.y = cvtpk(v[2], v[3]); *(GAS v2u*)(AO + m * DM + col) = pk; }
    }
    {
        const float ggc = F.in[15][c];
#pragma unroll
        for (int t = 0; t < 4; ++t) { const size_t m = (size_t)MP + 4 * b + t; float tot = 0.f;
#pragma unroll
            for (int k = 0; k < 8; ++k) tot += xch2[t * 8 + k];
            const float rg = 1.0f / sqrtf(tot * (1.0f / 512.0f) + EPS); AO[m * DM + 512 + c] = (bf16)f2bf(yg[t] * rg * ggc); }
    }
    __syncthreads();
}

__device__ __forceinline__ void p8_final(Frame& F) {
    const int gw = F.vcu * NWAVES + F.wave, NGW = F.G * NWAVES; const float* ss3 = (const float*)(F.ws + WS_SS3); const GAS f32x4* gr = (const GAS f32x4*)F.in[21] + F.lane;
    f32x4 gn[4];
#pragma unroll
    for (int j = 0; j < 4; ++j) gn[j] = gr[64 * j];
    for (int m = gw; m < M; m += NGW) {
        const f32x4 p0 = *(const GAS f32x4*)(ss3 + (size_t)m * 16), p1 = *(const GAS f32x4*)(ss3 + (size_t)m * 16 + 4), p2 = *(const GAS f32x4*)(ss3 + (size_t)m * 16 + 8), p3 = *(const GAS f32x4*)(ss3 + (size_t)m * 16 + 12);
        const float tot = (((p0[0] + p0[1]) + (p0[2] + p0[3])) + ((p1[0] + p1[1]) + (p1[2] + p1[3]))) + (((p2[0] + p2[1]) + (p2[2] + p2[3])) + ((p3[0] + p3[1]) + (p3[2] + p3[3])));
        const float rs = 1.0f / sqrtf(tot * (1.0f / DM) + EPS);
        GAS f32x4* xr = (GAS f32x4*)(F.out + (size_t)m * DM) + F.lane;
#pragma unroll
        for (int j = 0; j < 4; ++j) xr[64 * j] = xr[64 * j] * rs * gn[j];
    }
}

struct Args { const float* in[22]; float* out; unsigned char* ws; int ph_lo, ph_hi, li, pad; };
__global__ void __launch_bounds__(NWAVES * 64, 2) mk_fwd(Args args) {
    extern __shared__ __attribute__((aligned(16))) unsigned char lds[];
    Frame F;
    F.lds = (LAS unsigned char*)lds;
    F.MISC = (volatile LAS unsigned*)(F.lds + MISC_OFF);
    F.tid = threadIdx.x; F.lane = F.tid & 63; F.wave = __builtin_amdgcn_readfirstlane(F.tid >> 6);
    F.G = gridDim.x; { const int bx = blockIdx.x; F.vcu = (F.G % 8 == 0) ? (bx % 8) * (F.G / 8) + bx / 8 : bx; }
    unsigned char* ws = args.ws; F.ws = ws; F.out = args.out;
    F.ctl = (gu32*)(ws + WS_CTL);
#pragma unroll
    for (int i = 0; i < 22; ++i) F.in[i] = args.in[i];
    for (int u = F.tid; u < (LDS_BYTES - LDSCTL_OFF) / 4; u += NWAVES * 64) ((LAS unsigned*)(F.lds + LDSCTL_OFF))[u] = 0u;
    __syncthreads();
    XcdBarrier bar; bar.bar = (unsigned*)(F.ctl + CW_BAR); bar.x = 0; bar.st = nullptr;
    if (N_LAUNCHES == 1) bar = xcd_barrier_post((unsigned*)(F.ctl + CW_BAR), F.MISC + 8);
#define GRID_BAR() do { if (N_LAUNCHES == 1) xcd_barrier(bar); } while (0)
    const int lo = args.ph_lo, hi = args.ph_hi;
#define IN(k) (lo <= (k) && (k) < hi)
#define BOTH(k) (IN(k) && IN((k) + 1))
    bf16* XB = (bf16*)(ws + WS_XB); bf16* HB = (bf16*)(ws + WS_H); bf16* ZB = (bf16*)(ws + WS_Z); bf16* AO = (bf16*)(ws + WS_AO);
    float* SS1 = (float*)(ws + WS_SS1); float* SS2 = (float*)(ws + WS_SS2); float* SS3 = (float*)(ws + WS_SS3); float* SSV = (float*)(ws + WS_SSV);
    float* X = F.out + O_Y;

    if (IN(0)) { p0_prologue(F); if (BOTH(0)) GRID_BAR(); }
    if (IN(1)) {
        pg8::Gemm g{XB, (const bf16*)(ws + WS_WGU1), M, NGU, DM}; pg8::StaticOrder S; S.init(M, NGU, F.G, (int)blockIdx.x);
        pg8::EpiSwiGLU<false> E{HB, FF, nullptr};
        pg8::gemm_phase<pg8::EpiSwiGLU<false>, pg8::StaticOrder, PG8_ALIGN, PG8_SP2>(F.lds + RING_OFF, g, S, E);
        if (BOTH(1)) GRID_BAR();
    }
    if (IN(2)) {
        pg8::Gemm g{HB, (const bf16*)(ws + WS_WD1), M, DM, FF}; pg8::StaticOrder S; S.init(M, DM, F.G, (int)blockIdx.x);
        pg8::EpiRes<true> E{F.in[0], F.in[1] - (size_t)MP * DM, MP / 256, X, XB, SS1, 0.5f};
        pg8::gemm_phase<pg8::EpiRes<true>, pg8::StaticOrder, PG8_ALIGN, PG8_SP2>(F.lds + RING_OFF, g, S, E);
        if (BOTH(2)) GRID_BAR();
    }
    if (IN(3)) {
        pg8::Gemm g{XB, (const bf16*)(ws + WS_WIN), M, DIN, DM}; pg8::StaticOrder S; S.init(M, DIN, F.G, (int)blockIdx.x);
        pg8::EpiInProj E{ZB, SS1, (const float*)(ws + WS_ROPE), SSV, F.out, (long)O_KP, (long)O_KS, (long)(O_VP - O_KP), (long)(O_VS - O_KS)};
        pg8::gemm_phase<pg8::EpiInProj, pg8::StaticOrder, PG8_ALIGN, PG8_SP2>(F.lds + RING_OFF, g, S, E);
        if (BOTH(3)) GRID_BAR();
    }
    if (IN(4)) {
        for (int u = F.vcu; u < 128; u += F.G) p4_sample_unit(F, u);
        for (int u = F.vcu; u < 256; u += F.G) p4_attn_unit(F, u >> 6, u & 63);
        for (int u = F.vcu; u < 256; u += F.G) p4_gmlp_unit(F, u >> 6, u & 63);
        if (BOTH(4)) GRID_BAR();
    }
    if (IN(5)) {
        pg8::Gemm g{AO, (const bf16*)(ws + WS_WOUT), M, DM, DM}; pg8::StaticOrder S; S.init(M, DM, F.G, (int)blockIdx.x);
        pg8::EpiRes<true> E{X, X, 1 << 30, X, XB, SS2, 1.0f};
        pg8::gemm_phase<pg8::EpiRes<true>, pg8::StaticOrder, PG8_ALIGN, PG8_SP2>(F.lds + RING_OFF, g, S, E);
        if (BOTH(5)) GRID_BAR();
    }
    if (IN(6)) {
        pg8::Gemm g{XB, (const bf16*)(ws + WS_WGU2), M, NGU, DM}; pg8::StaticOrder S; S.init(M, NGU, F.G, (int)blockIdx.x);
        pg8::EpiSwiGLU<true> E{HB, FF, SS2};
        pg8::gemm_phase<pg8::EpiSwiGLU<true>, pg8::StaticOrder, PG8_ALIGN, PG8_SP2>(F.lds + RING_OFF, g, S, E);
        if (BOTH(6)) GRID_BAR();
    }
    if (IN(7)) {
        pg8::Gemm g{HB, (const bf16*)(ws + WS_WD2), M, DM, FF}; pg8::StaticOrder S; S.init(M, DM, F.G, (int)blockIdx.x);
        pg8::EpiRes<false> E{X, X, 1 << 30, X, nullptr, SS3, 0.5f};
        pg8::gemm_phase<pg8::EpiRes<false>, pg8::StaticOrder, PG8_ALIGN, PG8_SP2>(F.lds + RING_OFF, g, S, E);
        if (BOTH(7)) GRID_BAR();
    }
    if (IN(8)) p8_final(F);
#undef IN
#undef BOTH
}

extern "C" void kernel_launch(void* const* d_in, const int* in_sizes, int n_in, void* d_out, int out_size, void* d_ws, size_t ws_size, hipStream_t stream) {
    static int grid = 0;
    if (grid == 0) {
        if (n_in != 22 || in_sizes[0] != MP * DM || out_size != (int)O_END || ws_size < WS_END) { fprintf(stderr, "kernel_launch: unexpected shapes (n_in %d, in0 %d, out %d, ws %zu); nothing launched\n", n_in, n_in > 0 ? in_sizes[0] : -1, out_size, ws_size); grid = -1; return; }
        int dev = 0, cus = 0, per_cu = 0;
        if (hipGetDevice(&dev) != hipSuccess || hipDeviceGetAttribute(&cus, hipDeviceAttributeMultiprocessorCount, dev) != hipSuccess) { fprintf(stderr, "kernel_launch: device query failed\n"); grid = -1; return; }
        if (hipFuncSetAttribute((const void*)mk_fwd, hipFuncAttributeMaxDynamicSharedMemorySize, LDS_BYTES) != hipSuccess) { fprintf(stderr, "kernel_launch: hipFuncSetAttribute failed\n"); grid = -1; return; }
        if (hipOccupancyMaxActiveBlocksPerMultiprocessor(&per_cu, (const void*)mk_fwd, NWAVES * 64, LDS_BYTES) != hipSuccess || per_cu < 1) { fprintf(stderr, "kernel_launch: occupancy query reports %d workgroups per CU\n", per_cu); grid = -1; (void)hipGetLastError(); return; }
        (void)hipGetLastError();
        grid = cus;
    }
    if (grid < 0) return;
    if (hipMemsetAsync((char*)d_ws + WS_CTL, 0, CTL_ZERO_BYTES, stream) != hipSuccess) { fprintf(stderr, "kernel_launch: hipMemsetAsync failed\n"); return; }
    Args a{};
    for (int i = 0; i < 22; ++i) a.in[i] = (const float*)d_in[i];
    a.out = (float*)d_out; a.ws = (unsigned char*)d_ws;
    for (int li = 0; li < N_LAUNCHES; ++li) {
        a.ph_lo = (N_LAUNCHES == 1) ? 0 : li; a.ph_hi = (N_LAUNCHES == 1) ? N_PHASES : li + 1; a.li = li;
        hipLaunchKernelGGL(mk_fwd, dim3(grid), dim3(NWAVES * 64), LDS_BYTES, stream, a);
        const hipError_t le = hipPeekAtLastError();
        if (le != hipSuccess) { fprintf(stderr, "kernel_launch: launch %d failed: %s\n", li, hipGetErrorName(le)); break; }
    }
}
```

```cpp
#include <hip/hip_runtime.h>
#include <cstdio>
#include <cstdint>
#include <cmath>
namespace pg8 {
#define PG8_LAS __attribute__((address_space(3)))
typedef unsigned short bf16_t;
typedef short bf16x8 __attribute__((ext_vector_type(8)));
typedef float f32x4 __attribute__((ext_vector_type(4)));
typedef unsigned u32x4 __attribute__((ext_vector_type(4)));
constexpr int BM = 256, BK = 64, HALF = 128, HTB = HALF * BK * 2  , STAGE_BYTES = 8 * HTB, NXCD = 8, WGM = 8;

__host__ __device__ __forceinline__ int lds_byte(int r, int c) { const int st = (r >> 4) * 2 + (c >> 5), rr = r & 15, cc = c & 31, ob = rr * 64 + cc * 2; return st * 1024 + (ob ^ (((ob >> 9) & 1) << 5)); }
__host__ __device__ __forceinline__ void stage_rc(int b, int& R, int& C) { const int st = b / 1024, sb = b % 1024, swz = sb ^ (((sb >> 9) & 1) << 5); R = (st >> 1) * 16 + swz / 64; C = (st & 1) * 32 + (swz % 64) / 2; }
__host__ __device__ __forceinline__ int perm32(int rho) { const int n = rho >> 4, i = rho & 15; return 8 * (i >> 2) + 4 * n + (i & 3); }

struct Unit { int pm, pn; };
struct Gemm { const bf16_t* A; const bf16_t* Bt; int M, N, K; };

struct StaticOrder {
    int nM, nN, nwg, G, c;
    __host__ __device__ void init(int M, int N, int G_, int c_) { nM = M / BM; nN = N / BM; nwg = nM * nN; G = G_; c = c_; }
    __host__ __device__ bool next(int i, Unit& u) const {
        const long L = (long)i * G + c; if (L >= nwg) return false;
        int wgid = (int)L; { const int q = nwg / NXCD, r = nwg % NXCD, xcd = wgid % NXCD, off = wgid / NXCD; wgid = (xcd < r ? xcd * (q + 1) : r * (q + 1) + (xcd - r) * q) + off; }
        const int nig = WGM * nN, gid = wgid / nig, fm = gid * WGM, gsz = (nM - fm) < WGM ? (nM - fm) : WGM;
        u.pm = fm + ((wgid % nig) % gsz); u.pn = (wgid % nig) / gsz; return true;
    }
    __device__ __forceinline__ void a_ready(const Unit&) const {}
    __device__ __forceinline__ void done(const Unit&) const {}
};

__device__ __forceinline__ unsigned cvt_pk_bf16(float lo, float hi) { unsigned r; asm volatile("v_cvt_pk_bf16_f32 %0, %1, %2" : "=v"(r) : "v"(lo), "v"(hi)); return r; }
typedef float f32x2 __attribute__((ext_vector_type(2)));
constexpr float LOG2E = 1.4426950408889634f;
constexpr float RMS_EPS = 1e-6f;
__device__ __forceinline__ float xsum4(float s) { s += __shfl_xor(s, 16); s += __shfl_xor(s, 32); return s; }
__device__ __forceinline__ float row_rscale16(const float* ss, int row, int fq) {
    const f32x4 v = *(const f32x4*)(ss + (size_t)row * 16 + 4 * fq);
    const float s = xsum4((v[0] + v[1]) + (v[2] + v[3]));
    return __builtin_amdgcn_rsqf(s * (1.0f / 1024.0f) + RMS_EPS);
}
__device__ __forceinline__ float silu_mul(float g, float u) { return g * u * __builtin_amdgcn_rcpf(1.0f + __builtin_amdgcn_exp2f(-LOG2E * g)); }
__device__ __forceinline__ float gelu_tanh(float x) {
    const float t = x * (1.0f + 0.044715f * x * x);
    return x * __builtin_amdgcn_rcpf(1.0f + __builtin_amdgcn_exp2f(-2.0f * 0.7978845608028654f * LOG2E * t));
}
__device__ __forceinline__ u32x4 pack8(const f32x4& a, const f32x4& b) { u32x4 w; w.x = cvt_pk_bf16(a[0], a[1]); w.y = cvt_pk_bf16(a[2], a[3]); w.z = cvt_pk_bf16(b[0], b[1]); w.w = cvt_pk_bf16(b[2], b[3]); return w; }

template <bool SCALED> struct EpiSwiGLU {
    static constexpr bool PERM = true, AFTER_DRAIN = false;
    bf16_t* H; int ldh; const float* ss;
    __device__ __forceinline__ void operator()(const f32x4 (&acc)[2][2][4][2], const Unit& u, int wr, int wc, int fr, int fq) const {
        const int row0 = u.pm * BM + wr * 64 + fr, col0 = u.pn * HALF + wc * 32 + 8 * fq;
#pragma unroll
        for (int ai = 0; ai < 2; ++ai)
#pragma unroll
            for (int m = 0; m < 4; ++m) { const int row = row0 + ai * HALF + m * 16;
                float rs = 1.0f; if (SCALED) rs = row_rscale16(ss, row, fq);
                f32x4 h[2];
#pragma unroll
                for (int n = 0; n < 2; ++n) { const f32x4 g = acc[ai][0][m][n] * rs, v = acc[ai][1][m][n] * rs;
#pragma unroll
                    for (int i = 0; i < 4; ++i) h[n][i] = silu_mul(g[i], v[i]); }
                *(u32x4*)(H + (size_t)row * ldh + col0) = pack8(h[0], h[1]); }
    }
};

template <bool WB> struct EpiRes {
    static constexpr bool PERM = true, AFTER_DRAIN = false;
    const float* res_p; const float* res_s;
    int split_pm; float* X; bf16_t* XB; float* ss; float scale;
    __device__ __forceinline__ float apply4(int row, int col, const f32x4& v) const {
        const size_t off = (size_t)row * 1024 + col; const f32x4 r = *(const f32x4*)(res_s + off); const f32x4 o = r + v * scale;
        *(f32x4*)(X + off) = o;
        if (WB) { typedef unsigned u32x2_ __attribute__((ext_vector_type(2))); u32x2_ w; w.x = cvt_pk_bf16(o[0], o[1]); w.y = cvt_pk_bf16(o[2], o[3]); *(u32x2_*)(XB + off) = w; }
        return (o[0] * o[0] + o[1] * o[1]) + (o[2] * o[2] + o[3] * o[3]);
    }
    __device__ __forceinline__ void operator()(const f32x4 (&acc)[2][2][4][2], const Unit& u, int wr, int wc, int fr, int fq) const {
        const int row0 = u.pm * BM + wr * 64 + fr, col0 = u.pn * BM + wc * 32 + 8 * fq;
        const float* rb = (u.pm < split_pm) ? res_p : res_s;
#pragma unroll
        for (int ai = 0; ai < 2; ++ai)
#pragma unroll
            for (int m = 0; m < 4; ++m) { const int row = row0 + ai * HALF + m * 16; const size_t off = (size_t)row * 1024 + col0; float q = 0.f;
#pragma unroll
                for (int bj = 0; bj < 2; ++bj) {
                    const f32x4 r0 = *(const f32x4*)(rb + off + bj * HALF), r1 = *(const f32x4*)(rb + off + bj * HALF + 4);
                    const f32x4 o0 = r0 + acc[ai][bj][m][0] * scale, o1 = r1 + acc[ai][bj][m][1] * scale;
                    q += (o0[0] * o0[0] + o0[1] * o0[1]) + (o0[2] * o0[2] + o0[3] * o0[3]); q += (o1[0] * o1[0] + o1[1] * o1[1]) + (o1[2] * o1[2] + o1[3] * o1[3]);
                    *(f32x4*)(X + off + bj * HALF) = o0; *(f32x4*)(X + off + bj * HALF + 4) = o1;
                    if (WB) *(u32x4*)(XB + off + bj * HALF) = pack8(o0, o1); }
                q = xsum4(q);
                if (fq == 0) ss[(size_t)row * 16 + u.pn * 4 + wc] = q; }
    }
};

struct EpiInProj {
    static constexpr bool PERM = true, AFTER_DRAIN = false;
    bf16_t* Z; const float* ss1; const float* rope; float* ssv; float* outb; long o_kp, o_ks, d_p, d_s;
    __device__ __forceinline__ void operator()(const f32x4 (&acc)[2][2][4][2], const Unit& u, int wr, int wc, int fr, int fq) const {
        const int row0 = u.pm * BM + wr * 64 + fr, pn = u.pn, cb = pn * BM + wc * 64 + 8 * fq;
        const bool rot = (pn < 2) || (pn == 2 && wc < 2);
#pragma unroll
        for (int ai = 0; ai < 2; ++ai)
#pragma unroll
            for (int m = 0; m < 4; ++m) { const int row = row0 + ai * HALF + m * 16;
                const float rs = row_rscale16(ss1, row, fq);
                f32x4 a0 = acc[ai][0][m][0] * rs, a1 = acc[ai][0][m][1] * rs, b0 = acc[ai][1][m][0] * rs, b1 = acc[ai][1][m][1] * rs;
                if (rot) {
                    const int pi = (row < 16384) ? (row & 4095) : (4096 + (row & 3));
                    const float* ct = rope + (size_t)pi * 64 + 8 * fq;
                    const f32x4 c0 = *(const f32x4*)(ct), c1 = *(const f32x4*)(ct + 4), s0 = *(const f32x4*)(ct + 32), s1 = *(const f32x4*)(ct + 36);
                    const f32x4 x0 = a0 * c0 - b0 * s0, x1 = a1 * c1 - b1 * s1, y0 = b0 * c0 + a0 * s0, y1 = b1 * c1 + a1 * s1;
                    a0 = x0; a1 = x1; b0 = y0; b1 = y1;
                    if (pn < 2) { const float qs = 0.125f * LOG2E; a0 = a0 * qs; a1 = a1 * qs; b0 = b0 * qs; b1 = b1 * qs; }
                } else if (pn >= 3) {
#pragma unroll
                    for (int i = 0; i < 4; ++i) { a0[i] = gelu_tanh(a0[i]); a1[i] = gelu_tanh(a1[i]); b0[i] = gelu_tanh(b0[i]); b1[i] = gelu_tanh(b1[i]); }
                    if (pn >= 5) {
                        float q = (a0[0] * a0[0] + a0[1] * a0[1]) + (a0[2] * a0[2] + a0[3] * a0[3]); q += (a1[0] * a1[0] + a1[1] * a1[1]) + (a1[2] * a1[2] + a1[3] * a1[3]);
                        q += (b0[0] * b0[0] + b0[1] * b0[1]) + (b0[2] * b0[2] + b0[3] * b0[3]); q += (b1[0] * b1[0] + b1[1] * b1[1]) + (b1[2] * b1[2] + b1[3] * b1[3]);
                        q = xsum4(q);
                        if (fq == 0) ssv[(size_t)row * 8 + (pn - 5) * 4 + wc] = q; }
                }
                if (pn == 2) {
                    const bool smp = (u.pm >= 64); float* ob = outb + (smp ? o_ks : o_kp) + ((wc >= 2) ? (smp ? d_s : d_p) : 0); const int kvh = wc & 1; bool wr_ = false; size_t o = 0;
                    if (u.pm >= 64) { const int bs = (row - 16384) >> 2, t = row & 3; o = ((size_t)(bs * 128 + 124 + t) * 2 + kvh) * 64 + 8 * fq; wr_ = true; }
                    else if ((u.pm & 15) == 15 && ai == 1) { const int bp = row >> 12, t = (row & 4095) - 3968; o = ((size_t)(bp * 128 + t) * 2 + kvh) * 64 + 8 * fq; wr_ = true; }
                    if (wr_) { *(f32x4*)(ob + o) = a0; *(f32x4*)(ob + o + 4) = a1; *(f32x4*)(ob + o + 32) = b0; *(f32x4*)(ob + o + 36) = b1; }
                }
                bf16_t* zr = Z + (size_t)row * 1792 + cb;
                *(u32x4*)(zr) = pack8(a0, a1); *(u32x4*)(zr + 32) = pack8(b0, b1); }
    }
};
template <class Epi, class Sched, bool ALIGN_EPI = false, bool SP2 = false>
__device__ __forceinline__ void gemm_phase(PG8_LAS unsigned char* lds, const Gemm g, const Sched& S, const Epi& E) {
    const int tid = threadIdx.x, wid = __builtin_amdgcn_readfirstlane(tid >> 6), lane = tid & 63, wr = wid >> 2, wc = wid & 3, fr = lane & 15, fq = lane >> 4;
    const int K = g.K, nt = K / BK;
    unsigned voffA[2], voffB[2];
#pragma unroll
    for (int i = 0; i < 2; ++i) { int R, C; stage_rc(tid * 16 + i * 8192, R, C); const int Rb = Epi::PERM ? ((R & ~31) + perm32(R & 31)) : R;
        voffA[i] = (unsigned)(R * K + C) * 2u; voffB[i] = (unsigned)(Rb * K + C) * 2u; }
    const size_t kstep = (size_t)(BK * 2);
    const size_t hstep = (size_t)HALF * K * 2;
    const size_t tstep = 2 * hstep;
    const unsigned ldsw = (unsigned)wid * 1024u;
    const int aoff = lds_byte(wr * 64 + fr, fq * 8), boff = lds_byte(wc * 32 + fr, fq * 8);
#define PG8_SA(b, h) (((b) * 2 + (h)) * HTB)
#define PG8_SB(b, h) ((4 + (b) * 2 + (h)) * HTB)
#define PG8_STAGE(bufoff, gbase, voff) do { _Pragma("unroll") for (int _i = 0; _i < 2; ++_i) \
        __builtin_amdgcn_global_load_lds((const unsigned*)((const char*)(gbase) + (voff)[_i]), (PG8_LAS unsigned*)(lds + (bufoff) + ldsw + _i * 8192), 16, 0, 0); } while (0)
#define PG8_LDA(dst, b, h) do { _Pragma("unroll") for (int m = 0; m < 4; ++m) _Pragma("unroll") for (int k = 0; k < 2; ++k) dst[m][k] = *(const PG8_LAS bf16x8*)(lds + PG8_SA(b, h) + aoff + m * 2048 + k * 1024); } while (0)
#define PG8_LDB(dst, b, h) do { _Pragma("unroll") for (int n = 0; n < 2; ++n) _Pragma("unroll") for (int k = 0; k < 2; ++k) dst[n][k] = *(const PG8_LAS bf16x8*)(lds + PG8_SB(b, h) + boff + n * 2048 + k * 1024); } while (0)
#define PG8_MMA(ai, bj, At, Bt) do { __builtin_amdgcn_s_setprio(1); _Pragma("unroll") for (int m = 0; m < 4; ++m) _Pragma("unroll") for (int n = 0; n < 2; ++n) _Pragma("unroll") for (int k = 0; k < 2; ++k) \
        acc[ai][bj][m][n] = __builtin_amdgcn_mfma_f32_16x16x32_bf16(Bt[n][k], At[m][k], acc[ai][bj][m][n], 0, 0, 0); __builtin_amdgcn_s_setprio(0); } while (0)
#define PG8_WAIT_V(n) asm volatile("s_waitcnt vmcnt(" #n ")" ::: "memory")
#define PG8_WAIT_L(n) asm volatile("s_waitcnt lgkmcnt(" #n ")" ::: "memory")
#define PG8_BAR __builtin_amdgcn_s_barrier()
#define PG8_SCHED __builtin_amdgcn_sched_barrier(0)
    Unit cur, nxt; int ui = 0;
    if (!S.next(0, cur)) return;
    f32x4 acc[2][2][4][2];
#pragma unroll
    for (int a = 0; a < 2; ++a)
#pragma unroll
        for (int b = 0; b < 2; ++b)
#pragma unroll
            for (int m = 0; m < 4; ++m)
#pragma unroll
                for (int n = 0; n < 2; ++n) acc[a][b][m][n] = (f32x4){0.f, 0.f, 0.f, 0.f};
    bf16x8 At[4][2], B0[2][2], B1[2][2];
    const char* cA = (const char*)g.A + (size_t)cur.pm * tstep; const char* cB = (const char*)g.Bt + (size_t)cur.pn * tstep;
    S.a_ready(cur);
    if constexpr (SP2) {
        PG8_STAGE(PG8_SB(0, 0), cB, voffB); PG8_STAGE(PG8_SB(0, 1), cB + hstep, voffB); PG8_STAGE(PG8_SA(0, 0), cA, voffA); PG8_STAGE(PG8_SA(0, 1), cA + hstep, voffA);
        if (wr == 1) PG8_BAR;
        PG8_WAIT_V(2); PG8_BAR;
        PG8_STAGE(PG8_SB(1, 0), cB + kstep, voffB); PG8_STAGE(PG8_SA(1, 0), cA + kstep, voffA); PG8_STAGE(PG8_SB(1, 1), cB + hstep + kstep, voffB);
        PG8_WAIT_V(6); PG8_BAR;
    } else {
        PG8_STAGE(PG8_SB(0, 0), cB, voffB); PG8_STAGE(PG8_SA(0, 0), cA, voffA); PG8_STAGE(PG8_SB(0, 1), cB + hstep, voffB); PG8_STAGE(PG8_SA(0, 1), cA + hstep, voffA);
        if (wr == 1) PG8_BAR;
        PG8_WAIT_V(4); PG8_BAR;
        PG8_STAGE(PG8_SB(1, 0), cB + kstep, voffB); PG8_STAGE(PG8_SA(1, 0), cA + kstep, voffA); PG8_STAGE(PG8_SB(1, 1), cB + hstep + kstep, voffB);
        PG8_WAIT_V(6); PG8_BAR;
    }
    for (;;) {
        const bool has_next = S.next(ui + 1, nxt);
        const char* nA = has_next ? (const char*)g.A + (size_t)nxt.pm * tstep : cA; const char* nB = has_next ? (const char*)g.Bt + (size_t)nxt.pn * tstep : cB;
        for (int t = 0; t < nt; t += 2) {
            const bool last = (t == nt - 2);
            const char* a1 = cA + (size_t)(t + 1) * kstep;
            const char* a2 = last ? nA : cA + (size_t)(t + 2) * kstep; const char* b2 = last ? nB : cB + (size_t)(t + 2) * kstep;
            const char* a3 = a2 + kstep; const char* b3 = b2 + kstep;
            if (last && has_next) S.a_ready(nxt);
            if constexpr (SP2) {
            PG8_LDB(B0, 0, 0); PG8_LDB(B1, 0, 1); PG8_SCHED; PG8_LDA(At, 0, 0); PG8_STAGE(PG8_SA(1, 1), a1 + hstep, voffA);
            PG8_WAIT_V(8); PG8_WAIT_L(0); PG8_BAR; PG8_MMA(0, 0, At, B0); PG8_MMA(0, 1, At, B1); PG8_BAR; PG8_SCHED;
            PG8_LDA(At, 0, 1); PG8_STAGE(PG8_SB(0, 0), b2, voffB); PG8_STAGE(PG8_SB(0, 1), b2 + hstep, voffB); PG8_STAGE(PG8_SA(0, 0), a2, voffA);
            PG8_WAIT_V(8); PG8_WAIT_L(0); PG8_BAR; PG8_MMA(1, 0, At, B0); PG8_MMA(1, 1, At, B1); PG8_BAR; PG8_SCHED;
            PG8_LDB(B0, 1, 0); PG8_LDB(B1, 1, 1); PG8_SCHED; PG8_LDA(At, 1, 0); PG8_STAGE(PG8_SA(0, 1), a2 + hstep, voffA);
            PG8_WAIT_V(8); PG8_WAIT_L(0); PG8_BAR; PG8_MMA(0, 0, At, B0); PG8_MMA(0, 1, At, B1); PG8_BAR; PG8_SCHED;
            PG8_LDA(At, 1, 1); PG8_STAGE(PG8_SB(1, 0), b3, voffB); PG8_STAGE(PG8_SB(1, 1), b3 + hstep, voffB); PG8_STAGE(PG8_SA(1, 0), a3, voffA);
            PG8_WAIT_V(8); PG8_WAIT_L(0); PG8_BAR; PG8_MMA(1, 0, At, B0); PG8_MMA(1, 1, At, B1); PG8_BAR; PG8_SCHED;
            } else {
            PG8_LDB(B0, 0, 0); PG8_SCHED; PG8_LDA(At, 0, 0); PG8_STAGE(PG8_SA(1, 1), a1 + hstep, voffA);
            PG8_WAIT_L(8); PG8_BAR; PG8_WAIT_L(0); PG8_MMA(0, 0, At, B0); PG8_BAR; PG8_SCHED;
            PG8_LDB(B1, 0, 1); PG8_STAGE(PG8_SB(0, 0), b2, voffB);
            PG8_BAR; PG8_WAIT_L(0); PG8_MMA(0, 1, At, B1); PG8_BAR;
            PG8_LDA(At, 0, 1); PG8_STAGE(PG8_SA(0, 0), a2, voffA);
            PG8_BAR; PG8_WAIT_L(0); PG8_MMA(1, 0, At, B0); PG8_BAR; PG8_SCHED;
            PG8_STAGE(PG8_SB(0, 1), b2 + hstep, voffB);
            PG8_WAIT_V(6); PG8_BAR; PG8_MMA(1, 1, At, B1); PG8_BAR;
            PG8_LDB(B0, 1, 0); PG8_SCHED; PG8_LDA(At, 1, 0); PG8_STAGE(PG8_SA(0, 1), a2 + hstep, voffA);
            PG8_WAIT_L(8); PG8_BAR; PG8_WAIT_L(0); PG8_MMA(0, 0, At, B0); PG8_BAR; PG8_SCHED;
            PG8_LDB(B1, 1, 1); PG8_STAGE(PG8_SB(1, 0), b3, voffB);
            PG8_BAR; PG8_WAIT_L(0); PG8_MMA(0, 1, At, B1); PG8_BAR;
            PG8_LDA(At, 1, 1); PG8_STAGE(PG8_SA(1, 0), a3, voffA);
            PG8_BAR; PG8_WAIT_L(0); PG8_MMA(1, 0, At, B0); PG8_BAR; PG8_SCHED;
            PG8_STAGE(PG8_SB(1, 1), b3 + hstep, voffB);
            PG8_WAIT_V(6); PG8_BAR; PG8_MMA(1, 1, At, B1); PG8_BAR;
            }
        }
        if constexpr (ALIGN_EPI) { if (wr == 0) PG8_BAR; }
        if constexpr (!Epi::AFTER_DRAIN) { E(acc, cur, wr, wc, fr, fq); S.done(cur); }
        if (!has_next) break;
#pragma unroll
        for (int a = 0; a < 2; ++a)
#pragma unroll
            for (int b = 0; b < 2; ++b)
#pragma unroll
                for (int m = 0; m < 4; ++m)
#pragma unroll
                    for (int n = 0; n < 2; ++n) acc[a][b][m][n] = (f32x4){0.f, 0.f, 0.f, 0.f};
        cur = nxt; cA = nA; cB = nB; ++ui;
        if constexpr (ALIGN_EPI) { if (wr == 1) PG8_BAR; }
    }
    PG8_WAIT_V(0);
    if constexpr (!ALIGN_EPI) { if (wr == 0) PG8_BAR; }
    PG8_BAR;
    if constexpr (Epi::AFTER_DRAIN) { E.fused(acc, cur, wr, wc, fr, fq, lds, wid, lane); S.done(cur); }
#undef PG8_SA
#undef PG8_SB
#undef PG8_STAGE
#undef PG8_LDA
#undef PG8_LDB
#undef PG8_MMA
#undef PG8_WAIT_V
#undef PG8_WAIT_L
#undef PG8_BAR
#undef PG8_SCHED
}
}

#ifndef PG8_SP2
#define PG8_SP2 true
#endif
#ifndef PG8_ALIGN
#define PG8_ALIGN true
#endif
#ifndef MK_N_LAUNCHES
#define MK_N_LAUNCHES 1
#endif
constexpr int NWAVES = 8;
constexpr int N_PHASES = 9;
constexpr int N_LAUNCHES = MK_N_LAUNCHES;
constexpr int DM = 1024, FF = 2816, NGU = 2 * FF, DIN = 1792;
constexpr int MP = 16384, MS = 512, M = MP + MS;
constexpr int ZQ = 0, ZK = 512, ZV = 640, ZU = 768, ZG = 1280;
constexpr float EPS = 1e-6f, LOG2E_F = 1.4426950408889634f;
constexpr size_t O_Y = 0, O_KP = 17301504, O_VP = 17367040, O_KS = 17432576, O_VS = 19529728, O_GP = 21626880, O_GS = 21889024, O_END = 22151168;
constexpr size_t MiB = 1u << 20;
constexpr size_t WS_CTL = 0, CTL_ZERO_BYTES = 1 * MiB;
constexpr size_t WS_WGU1 = 1 * MiB, WS_WD1 = 12 * MiB, WS_WIN = 18 * MiB, WS_WOUT = 22 * MiB, WS_WGU2 = 24 * MiB, WS_WD2 = 35 * MiB;
constexpr size_t WS_TRIL = 41 * MiB, WS_ROPE = 42 * MiB, WS_SS1 = 44 * MiB, WS_SS2 = 46 * MiB, WS_SS3 = 48 * MiB, WS_SSV = 50 * MiB;
constexpr size_t WS_XB = 52 * MiB;
constexpr size_t WS_H = 86 * MiB;
constexpr size_t WS_Z = WS_H, WS_AO = WS_H + (size_t)M * DIN * 2;
constexpr size_t WS_END = WS_H + (size_t)M * FF * 2;
static_assert(WS_AO + (size_t)M * DM * 2 <= WS_END && WS_END <= 256 * MiB && WS_XB + (size_t)M * DM * 2 <= WS_H, "d_ws map");
static_assert(WS_WGU1 + (size_t)NGU * DM * 2 <= WS_WD1 && WS_WD1 + (size_t)DM * FF * 2 <= WS_WIN && WS_WIN + (size_t)DIN * DM * 2 <= WS_WOUT && WS_WGU2 + (size_t)NGU * DM * 2 <= WS_WD2 && WS_WD2 + (size_t)DM * FF * 2 <= WS_TRIL, "weights map");
static_assert(WS_ROPE + 4100 * 64 * 4 <= WS_SS1 && WS_SS1 + (size_t)M * 64 <= WS_SS2 && WS_SSV + (size_t)M * 32 <= WS_XB, "small tables map");
constexpr int CW_TMO = 0, CW_CODE = 1, CW_BAR = 4096;
constexpr int RING_OFF = 0, PHASE_BYTES = 139264;
constexpr int XCH_OFF = 135168;
constexpr int LDSCTL_OFF = PHASE_BYTES, MISC_OFF = LDSCTL_OFF + 320;
constexpr int LDS_BYTES = 147456;
static_assert(MISC_OFF + 128 <= LDS_BYTES && XCH_OFF + 4096 <= PHASE_BYTES, "LDS map");

#define GAS __attribute__((address_space(1)))
#define LAS __attribute__((address_space(3)))
typedef unsigned short bf16;
typedef unsigned v4u __attribute__((ext_vector_type(4)));
typedef unsigned v2u __attribute__((ext_vector_type(2)));
typedef float f32x4 __attribute__((ext_vector_type(4)));
typedef short bf16x8 __attribute__((ext_vector_type(8)));
typedef short s16x4 __attribute__((ext_vector_type(4)));
typedef GAS unsigned gu32;
typedef GAS unsigned long long gu64;
#define RLX_AGENT __ATOMIC_RELAXED, __HIP_MEMORY_SCOPE_AGENT
#define LDS_WAIT() asm volatile("s_waitcnt lgkmcnt(0)" ::: "memory")
#define VM_WAIT() asm volatile("s_waitcnt vmcnt(0)" ::: "memory")
__device__ __forceinline__ unsigned f2bf(float f) { unsigned u = __builtin_bit_cast(unsigned, f); return (u + 0x7fffu + ((u >> 16) & 1u)) >> 16; }
__device__ __forceinline__ unsigned pk2(float lo, float hi) { return f2bf(lo) | (f2bf(hi) << 16); }
__device__ __forceinline__ float bf_lo(unsigned w) { return __builtin_bit_cast(float, w << 16); }
__device__ __forceinline__ float bf_hi(unsigned w) { return __builtin_bit_cast(float, w & 0xffff0000u); }
__device__ __forceinline__ float xs4(float s) { s += __shfl_xor(s, 16); s += __shfl_xor(s, 32); return s; }
__device__ __forceinline__ float wave_sum(float v) {
#pragma unroll
    for (int o = 1; o < 64; o <<= 1) v += __shfl_xor(v, o);
    return v;
}
#define XB_TMO      128
#define XB_XCNT(j)  (256  + 64 * (j))
#define XB_XSUB(j)  (1280 + 64 * (j))
#define XB_XGEN(j)  (2304 + 64 * (j))
#define XB_TOP      3328
#define XB_TOPGEN   3392
#define XCD_BAR_WORDS 3456
#define XB_SPIN_CAP (1u << 18)

__device__ __forceinline__ unsigned xb_ld(unsigned* p)              { return __hip_atomic_load(p, __ATOMIC_RELAXED, __HIP_MEMORY_SCOPE_AGENT); }
__device__ __forceinline__ unsigned xb_add(unsigned* p, unsigned v) { return __hip_atomic_fetch_add(p, v, __ATOMIC_RELAXED, __HIP_MEMORY_SCOPE_AGENT); }
__device__ __forceinline__ unsigned xb_xcc_id() { return (unsigned)__builtin_amdgcn_s_getreg((3 << 11) | 20) & 0xFu; }
#define XB_SPIN(cond, bar) do { unsigned _sp = 0; while (cond) { __builtin_amdgcn_s_sleep(1); \
    if ((++_sp & 255u) == 0u) { if (xb_ld(&(bar)[XB_TMO])) break; if (_sp > XB_SPIN_CAP) { atomicAdd(&(bar)[XB_TMO], 1u); break; } } } } while (0)

struct XcdBarrier {
    unsigned* bar; unsigned x;
    volatile LAS unsigned* st;
};

__device__ __forceinline__ XcdBarrier xcd_barrier_post(unsigned* bar, volatile LAS unsigned* st) {
    XcdBarrier b; b.bar = bar; b.x = xb_xcc_id(); b.st = st;
    if (threadIdx.x == 0) (void)xb_add(&bar[XB_XCNT(b.x)], 1u);
    return b;
}
__device__ __forceinline__ void xcd_barrier_complete(unsigned* bar, unsigned x, unsigned& nloc, unsigned& nx) {
    const unsigned G = gridDim.x * gridDim.y * gridDim.z;
    unsigned sum, cnt, mine, sp = 0u;
    for (;;) {
        sum = 0u; cnt = 0u; mine = 0u;
#pragma unroll
        for (unsigned j = 0; j < 16; ++j) { const unsigned c = xb_ld(&bar[XB_XCNT(j)]); sum += c; cnt += (c > 0u) ? 1u : 0u; mine = (j == x) ? c : mine; }
        if (sum == G) break;
        __builtin_amdgcn_s_sleep(1);
        if ((++sp & 255u) == 0u) { if (xb_ld(&bar[XB_TMO])) break; if (sp > XB_SPIN_CAP) { atomicAdd(&bar[XB_TMO], 1u); break; } }
    }
    nloc = mine > 0u ? mine : 1u; nx = cnt > 0u ? cnt : 1u;
}

__device__ __forceinline__ void xcd_barrier(const XcdBarrier& b) {
    asm volatile("s_waitcnt vmcnt(0)" ::: "memory");
    __syncthreads();
    if (threadIdx.x == 0) {
        unsigned* bar = b.bar;
        __builtin_amdgcn_s_waitcnt(0);
        unsigned nloc = b.st[0], nx = b.st[1];
        if (nloc == 0u) { xcd_barrier_complete(bar, b.x, nloc, nx); b.st[0] = nloc; b.st[1] = nx; }
        const unsigned old = xb_add(&bar[XB_XSUB(b.x)], 1u);
        const unsigned gen = old / nloc;
        if (old + 1u == (gen + 1u) * nloc) {
            __builtin_amdgcn_fence(__ATOMIC_RELEASE, "agent");
            asm volatile("s_waitcnt vmcnt(0)" ::: "memory");
            const unsigned og = xb_add(&bar[XB_TOP], 1u);
            const unsigned tg = og / nx;
            if (og + 1u == (tg + 1u) * nx) xb_add(&bar[XB_TOPGEN], 1u);
            else XB_SPIN(xb_ld(&bar[XB_TOPGEN]) == tg, bar);
            __builtin_amdgcn_fence(__ATOMIC_ACQUIRE, "agent");
            xb_add(&bar[XB_XGEN(b.x)], 1u);
            asm volatile("s_waitcnt vmcnt(0)" ::: "memory");
        } else {
            XB_SPIN(xb_ld(&bar[XB_XGEN(b.x)]) == gen, bar);
            __builtin_amdgcn_fence(__ATOMIC_ACQUIRE, "agent");
            asm volatile("s_waitcnt vmcnt(0)" ::: "memory");
        }
    }
    __syncthreads();
}


struct Frame {
    LAS unsigned char* lds;
    volatile LAS unsigned* MISC;
    gu32* ctl;
    int tid, lane, wave;
    int vcu, G;
    const float* in[22]; float* out; unsigned char* ws;
};
__constant__ float c_inv_freq[32] = {
    1.000000000e+00f, 7.498942018e-01f, 5.623413324e-01f, 4.216965139e-01f, 3.162277639e-01f, 2.371373773e-01f, 1.778279394e-01f, 1.333521456e-01f,
    1.000000015e-01f, 7.498942316e-02f, 5.623413250e-02f, 4.216964915e-02f, 3.162277490e-02f, 2.371373773e-02f, 1.778279431e-02f, 1.333521400e-02f,
    9.999999776e-03f, 7.498942316e-03f, 5.623413250e-03f, 4.216964822e-03f, 3.162277630e-03f, 2.371373819e-03f, 1.778279431e-03f, 1.333521446e-03f,
    1.000000047e-03f, 7.498941850e-04f, 5.623413017e-04f, 4.216965172e-04f, 3.162277571e-04f, 2.371373703e-04f, 1.778279402e-04f, 1.333521504e-04f };

__device__ __forceinline__ void p0_transpose_item(const float* W, int K, int N, bf16* WT, int mode, const float* gk, LAS float* scr, int item, int lane) {
    const int nblk = N / 32, kb = item / nblk, nb = item % nblk, k0 = 64 * kb, n0 = 32 * nb;
    int rb = n0;
    if (mode == 1) rb = 256 * (n0 >> 7) + (n0 & 127);
    else if (mode == 2) rb = 256 * (n0 >> 7) + 128 + (n0 & 127);
    else if (mode == 3) rb = (n0 & ~0xE0) | (((n0 >> 5) & 1) << 7) | (((n0 >> 6) & 3) << 5);
#pragma unroll 8
    for (int i = 0; i < 32; ++i) { const int kk = 2 * i + (lane >> 5); scr[kk * 33 + (lane & 31)] = W[(size_t)(k0 + kk) * N + n0 + (lane & 31)]; }
    LDS_WAIT(); asm volatile("" ::: "memory");
    const int c = lane & 7;
    float g8[8];
#pragma unroll
    for (int e = 0; e < 8; ++e) g8[e] = gk ? gk[k0 + 8 * c + e] : 1.0f;
#pragma unroll
    for (int j = 0; j < 4; ++j) { const int n = (lane >> 3) + 8 * j; const LAS float* s = scr + (8 * c) * 33 + n;
        v4u o; o.x = pk2(s[0 * 33] * g8[0], s[1 * 33] * g8[1]); o.y = pk2(s[2 * 33] * g8[2], s[3 * 33] * g8[3]); o.z = pk2(s[4 * 33] * g8[4], s[5 * 33] * g8[5]); o.w = pk2(s[6 * 33] * g8[6], s[7 * 33] * g8[7]);
        *(GAS v4u*)(WT + (size_t)(rb + n) * K + k0 + 8 * c) = o; }
    LDS_WAIT(); asm volatile("" ::: "memory");
}
__device__ __forceinline__ void rms_row_to_bf16(int lane, const float* xrow, const float* gain, bf16* orow) {
    const GAS f32x4* xr = (const GAS f32x4*)xrow + lane; const GAS f32x4* gr = (const GAS f32x4*)gain + lane;
    f32x4 v[4]; float s = 0.f;
#pragma unroll
    for (int j = 0; j < 4; ++j) { v[j] = xr[64 * j]; s += (v[j].x * v[j].x + v[j].y * v[j].y) + (v[j].z * v[j].z + v[j].w * v[j].w); }
    const float rs = 1.0f / sqrtf(wave_sum(s) * (1.f / DM) + EPS);
    GAS unsigned long long* o8 = (GAS unsigned long long*)orow + lane;
#pragma unroll
    for (int j = 0; j < 4; ++j) { const f32x4 g = gr[64 * j]; o8[64 * j] = (unsigned long long)pk2(v[j].x * rs * g.x, v[j].y * rs * g.y) | ((unsigned long long)pk2(v[j].z * rs * g.z, v[j].w * rs * g.w) << 32); }
}
__device__ __forceinline__ void sincos_d(float ang, float& sn, float& cs) {
    const double x = (double)ang; const double kd = __builtin_rint(x * 0.63661977236758134308);
    const double r = __builtin_fma(-kd, 6.123233995736766036e-17, __builtin_fma(-kd, 1.5707963267948966192, x)); const double r2 = r * r;
    double ps = -7.6471637318198164759e-13; ps = ps * r2 + 1.6059043836821614599e-10; ps = ps * r2 - 2.5052108385441718775e-08; ps = ps * r2 + 2.7557319223985890653e-06; ps = ps * r2 - 1.9841269841269841270e-04;
    ps = ps * r2 + 8.3333333333333333333e-03; ps = ps * r2 - 1.6666666666666666667e-01; const double s = r + r * r2 * ps;
    double pc = 4.7794773323873852974e-14; pc = pc * r2 - 1.1470745597729724714e-11; pc = pc * r2 + 2.0876756987868098979e-09; pc = pc * r2 - 2.7557319223985890653e-07; pc = pc * r2 + 2.4801587301587301587e-05;
    pc = pc * r2 - 1.3888888888888888889e-03; pc = pc * r2 + 4.1666666666666666667e-02; pc = pc * r2 - 0.5; const double c = 1.0 + r2 * pc;
    const int q = (int)kd & 3;
    const double ss = (q & 1) ? c : s, cc = (q & 1) ? s : c;
    sn = (float)((q & 2) ? -ss : ss); cs = (float)(((q + 1) & 2) ? -cc : cc);
}
__device__ __forceinline__ void p0_prologue(Frame& F) {
    LAS float* scr = (LAS float*)(F.lds + RING_OFF + F.wave * 16384);
    const int gw = F.vcu * NWAVES + F.wave, NGW = F.G * NWAVES;
    bf16* Wgu1 = (bf16*)(F.ws + WS_WGU1); bf16* Wd1 = (bf16*)(F.ws + WS_WD1); bf16* Win = (bf16*)(F.ws + WS_WIN); bf16* Wout = (bf16*)(F.ws + WS_WOUT); bf16* Wgu2 = (bf16*)(F.ws + WS_WGU2); bf16* Wd2 = (bf16*)(F.ws + WS_WD2);
    constexpr int I_GU = (DM / 64) * (FF / 32), I_D = (FF / 64) * (DM / 32), I_IN = (DM / 64) * (DIN / 32), I_OUT = (DM / 64) * (DM / 32);
    constexpr int NITEMS = 4 * I_GU + 2 * I_D + I_IN + I_OUT;
    for (int it = gw; it < NITEMS; it += NGW) {
        int r = it;
        if (r < I_GU) { p0_transpose_item(F.in[5], DM, FF, Wgu1, 1, nullptr, scr, r, F.lane); continue; } r -= I_GU;
        if (r < I_GU) { p0_transpose_item(F.in[6], DM, FF, Wgu1, 2, nullptr, scr, r, F.lane); continue; } r -= I_GU;
        if (r < I_D) { p0_transpose_item(F.in[7], FF, DM, Wd1, 0, nullptr, scr, r, F.lane); continue; } r -= I_D;
        if (r < I_IN) { p0_transpose_item(F.in[9], DM, DIN, Win, 3, F.in[8], scr, r, F.lane); continue; } r -= I_IN;
        if (r < I_OUT) { p0_transpose_item(F.in[16], DM, DM, Wout, 0, nullptr, scr, r, F.lane); continue; } r -= I_OUT;
        if (r < I_GU) { p0_transpose_item(F.in[18], DM, FF, Wgu2, 1, F.in[17], scr, r, F.lane); continue; } r -= I_GU;
        if (r < I_GU) { p0_transpose_item(F.in[19], DM, FF, Wgu2, 2, F.in[17], scr, r, F.lane); continue; } r -= I_GU;
        p0_transpose_item(F.in[20], FF, DM, Wd2, 0, nullptr, scr, r, F.lane);
    }
    bf16* XB = (bf16*)(F.ws + WS_XB);
    for (int m = gw; m < M; m += NGW) { const float* xr = (m < MP) ? F.in[0] + (size_t)m * DM : F.in[1] + (size_t)(m - MP) * DM; rms_row_to_bf16(F.lane, xr, F.in[4], XB + (size_t)m * DM); }
    float* rope = (float*)(F.ws + WS_ROPE);
    const int gt = F.vcu * (NWAVES * 64) + F.tid, NGT = F.G * NWAVES * 64;
    for (int e = gt; e < 4100 * 32; e += NGT) { const int pi = e >> 5, i = e & 31; const int pos = pi < 4096 ? pi : 16384 + (pi - 4096);
        const float ang = (float)pos * c_inv_freq[i]; float sn, cs; sincos_d(ang, sn, cs); rope[pi * 64 + i] = cs; rope[pi * 64 + 32 + i] = sn; }
    bf16* tril = (bf16*)(F.ws + WS_TRIL);
    for (int e = gt; e < 8 * 128 * 128; e += NGT) { const int s = e & 127, t = (e >> 7) & 127; tril[e] = (bf16)f2bf(s <= t ? F.in[12][e] : 0.f); }
}

constexpr int KVS = 160;
constexpr int GVS = 1056;
typedef short v4i16_t __attribute__((ext_vector_type(4)));
__device__ __forceinline__ s16x4 vtr(LAS const unsigned char* p) { return __builtin_bit_cast(s16x4, __builtin_amdgcn_ds_read_tr16_b64_v4i16((LAS v4i16_t*)p)); }
__device__ __forceinline__ unsigned cvtpk(float lo, float hi) { unsigned r; asm volatile("v_cvt_pk_bf16_f32 %0, %1, %2" : "=v"(r) : "v"(lo), "v"(hi)); return r; }
#define MFMA16(a, b, c) __builtin_amdgcn_mfma_f32_16x16x32_bf16((a), (b), (c), 0, 0, 0)
template <int K, class Epi> __device__ __forceinline__ void mini_gemm(LAS unsigned char* lds, const bf16* A, const bf16* Bt, int rowbase, int tile, const Epi& E, int tid, int wave, int lane) {
    constexpr int KW = K / 8, NKS = KW / 32; static_assert(KW % 32 == 0, "K / 8 must be a multiple of 32");
    const int rt = tile >> 4, ct = tile & 15, g = lane >> 4, fr = lane & 15;
    const bf16* ap = A + (size_t)(rt * 32 + fr) * K + wave * KW + 8 * g;
    const bf16* bp = Bt + (size_t)(ct * 64 + fr) * K + wave * KW + 8 * g;
    f32x4 acc[2][4];
#pragma unroll
    for (int i = 0; i < 2; ++i)
#pragma unroll
        for (int c = 0; c < 4; ++c) acc[i][c] = (f32x4){0.f, 0.f, 0.f, 0.f};
#pragma unroll
    for (int ks = 0; ks < NKS; ++ks) { bf16x8 a[2], b[4];
#pragma unroll
        for (int i = 0; i < 2; ++i) a[i] = *(const GAS bf16x8*)(ap + (size_t)i * 16 * K + ks * 32);
#pragma unroll
        for (int c = 0; c < 4; ++c) b[c] = *(const GAS bf16x8*)(bp + (size_t)c * 16 * K + ks * 32);
#pragma unroll
        for (int i = 0; i < 2; ++i)
#pragma unroll
            for (int c = 0; c < 4; ++c) acc[i][c] = MFMA16(b[c], a[i], acc[i][c]); }
    LAS f32x4* P = (LAS f32x4*)lds;
#pragma unroll
    for (int i = 0; i < 2; ++i)
#pragma unroll
        for (int c = 0; c < 4; ++c) P[((wave * 2 + i) * 4 + c) * 64 + lane] = acc[i][c];
    __syncthreads();
    const int r = tid >> 4, cg = tid & 15; const int src = (((r >> 4) * 4 + (cg >> 2)) * 64) + (r & 15) + 16 * (cg & 3);
    f32x4 sum = P[src];
#pragma unroll
    for (int w = 1; w < 8; ++w) sum = sum + P[w * 512 + src];
    float q = E.apply4(rowbase + rt * 32 + r, ct * 64 + 4 * cg, sum);
    q += __shfl_xor(q, 1); q += __shfl_xor(q, 2); q += __shfl_xor(q, 4); q += __shfl_xor(q, 8);
    if (cg == 0) E.ss[(size_t)(rowbase + rt * 32 + r) * 16 + ct] = q;
    __syncthreads();
}

template <int NF> __device__ __forceinline__ void attn_core(f32x4 (&o)[4], bf16x8 qf0, bf16x8 qf1, LAS const unsigned char* kp, LAS const unsigned char* vp, int slot0, int slot_lo, int slot_hi, float sink2) {
    f32x4 s[NF];
#pragma unroll
    for (int f = 0; f < NF; ++f) { const bf16x8 k0 = *(const LAS bf16x8*)(kp + f * 16 * KVS), k1 = *(const LAS bf16x8*)(kp + f * 16 * KVS + 64);
        s[f] = MFMA16(k0, qf0, ((f32x4){0.f, 0.f, 0.f, 0.f})); s[f] = MFMA16(k1, qf1, s[f]); }
    float mx = sink2;
#pragma unroll
    for (int f = 0; f < NF; ++f)
#pragma unroll
        for (int r = 0; r < 4; ++r) { const int slot = slot0 + 16 * f + r; const float v = (slot >= slot_lo && slot <= slot_hi) ? s[f][r] : -INFINITY; s[f][r] = v; mx = fmaxf(mx, v); }
    mx = fmaxf(mx, __shfl_xor(mx, 16)); mx = fmaxf(mx, __shfl_xor(mx, 32));
    float l = 0.f;
#pragma unroll
    for (int f = 0; f < NF; ++f)
#pragma unroll
        for (int r = 0; r < 4; ++r) { const float p = __builtin_amdgcn_exp2f(s[f][r] - mx); s[f][r] = p; l += p; }
    l = xs4(l) + __builtin_amdgcn_exp2f(sink2 - mx);
#pragma unroll
    for (int d0 = 0; d0 < 4; ++d0) o[d0] = (f32x4){0.f, 0.f, 0.f, 0.f};
#pragma unroll
    for (int kk = 0; kk < (NF + 1) / 2; ++kk) { const int f0 = 2 * kk, f1 = (2 * kk + 1 < NF) ? 2 * kk + 1 : f0; const bool two = (2 * kk + 1 < NF);
        v4u pw; pw.x = cvtpk(s[f0][0], s[f0][1]); pw.y = cvtpk(s[f0][2], s[f0][3]); pw.z = two ? cvtpk(s[f1][0], s[f1][1]) : 0u; pw.w = two ? cvtpk(s[f1][2], s[f1][3]) : 0u;
        const bf16x8 pb = __builtin_bit_cast(bf16x8, pw);
#pragma unroll
        for (int d0 = 0; d0 < 4; ++d0) { const s16x4 lo = vtr(vp + f0 * 16 * KVS + d0 * 32), hi = vtr(vp + f1 * 16 * KVS + d0 * 32);
            const bf16x8 va = (bf16x8){lo[0], lo[1], lo[2], lo[3], hi[0], hi[1], hi[2], hi[3]};
            o[d0] = MFMA16(va, pb, o[d0]); } }
    const float inv = 1.0f / l;
#pragma unroll
    for (int d0 = 0; d0 < 4; ++d0) o[d0] = o[d0] * inv;
}

__device__ __forceinline__ void p4_attn_unit(Frame& F, int b, int j) {
    const bf16* Z = (const bf16*)(F.ws + WS_Z); bf16* AO = (bf16*)(F.ws + WS_AO);
    LAS unsigned char* Kl = F.lds; LAS unsigned char* Vl = F.lds + 2 * 192 * KVS; LAS float* xch = (LAS float*)(F.lds + XCH_OFF);
    const int lane = F.lane, w = F.wave, g = lane >> 4, ql = lane & 15;
    const int kb0 = 64 * j - 128;
    for (int i = F.tid; i < 192 * 32; i += NWAVES * 64) { const int slot = i >> 5, within = i & 31, pos = kb0 + slot;
        v4u v = (v4u){0u, 0u, 0u, 0u};
        if (pos >= 0) v = *(const GAS v4u*)(Z + (size_t)(b * 4096 + pos) * DIN + ZK + within * 8);
        LAS unsigned char* dst = ((within & 16) ? Vl : Kl) + ((within >> 3) & 1) * (192 * KVS) + slot * KVS + (within & 7) * 16;
        *(LAS v4u*)dst = v; }
    __syncthreads();
    const int kvh = w >> 2; const float sink2 = F.in[10][w] * LOG2E_F;
    LAS const unsigned char* Kb = Kl + kvh * (192 * KVS); LAS const unsigned char* Vb = Vl + kvh * (192 * KVS);
    const int smin = (kb0 < 0) ? -kb0 : 0;
    f32x4 o[4][4];
#pragma unroll
    for (int qf = 0; qf < 4; ++qf) {
        const size_t m = (size_t)b * 4096 + 64 * j + 16 * qf + ql;
        const bf16x8 qf0 = *(const GAS bf16x8*)(Z + m * DIN + ZQ + w * 64 + 8 * g), qf1 = *(const GAS bf16x8*)(Z + m * DIN + ZQ + w * 64 + 32 + 8 * g);
        const int lo = 16 * qf + ql + 1;
        attn_core<9>(o[qf], qf0, qf1, Kb + (16 * qf + ql) * KVS + 16 * g, Vb + (16 * qf + 4 * g + (ql >> 2)) * KVS + 8 * (ql & 3), 16 * qf + 4 * g, lo > smin ? lo : smin, 16 * qf + ql + 128, sink2);
        float q = 0.f;
#pragma unroll
        for (int d0 = 0; d0 < 4; ++d0) q += (o[qf][d0][0] * o[qf][d0][0] + o[qf][d0][1] * o[qf][d0][1]) + (o[qf][d0][2] * o[qf][d0][2] + o[qf][d0][3] * o[qf][d0][3]);
        q = xs4(q);
        if (g == 0) xch[(16 * qf + ql) * 8 + w] = q;
    }
    __syncthreads();
    const float* ga = F.in[14];
#pragma unroll
    for (int qf = 0; qf < 4; ++qf) {
        const f32x4 t0 = *(const LAS f32x4*)(xch + (16 * qf + ql) * 8), t1 = *(const LAS f32x4*)(xch + (16 * qf + ql) * 8 + 4);
        const float tot = ((t0[0] + t0[1]) + (t0[2] + t0[3])) + ((t1[0] + t1[1]) + (t1[2] + t1[3]));
        const float ra = 1.0f / sqrtf(tot * (1.0f / 512.0f) + EPS);
        const size_t m = (size_t)b * 4096 + 64 * j + 16 * qf + ql;
#pragma unroll
        for (int d0 = 0; d0 < 4; ++d0) { const int col = w * 64 + 16 * d0 + 4 * g; const f32x4 gn = *(const GAS f32x4*)(ga + col); const f32x4 v = o[qf][d0] * ra * gn;
            v2u pk; pk.x = cvtpk(v[0], v[1]); pk.y = cvtpk(v[2], v[3]); *(GAS v2u*)(AO + m * DM + col) = pk; }
    }
    __syncthreads();
}

__device__ __forceinline__ void p4_gmlp_unit(Frame& F, int b, int hc) {
    const bf16* Z = (const bf16*)(F.ws + WS_Z); bf16* AO = (bf16*)(F.ws + WS_AO); const float* ssv = (const float*)(F.ws + WS_SSV); const bf16* tril = (const bf16*)(F.ws + WS_TRIL);
    LAS unsigned char* Gl = F.lds; LAS float* xch = (LAS float*)(F.lds + XCH_OFF);
    const int lane = F.lane, w = F.wave, g = lane >> 4, ql = lane & 15;
    const int n = hc >> 1, half = hc & 1, ns = 64 * (half + 1); const size_t m0 = (size_t)b * 4096 + 128 * n;
    {
        const int cc = F.tid & 63; const f32x4 gv0 = *(const GAS f32x4*)(F.in[11] + 8 * cc), gv1 = *(const GAS f32x4*)(F.in[11] + 8 * cc + 4);
        const bool wout = (n == 31 && half == 1); float* ogp = F.out + O_GP;
        for (int sr = w; sr < ns; sr += NWAVES) { const size_t m = m0 + sr;
            const f32x4 p0 = *(const GAS f32x4*)(ssv + m * 8), p1 = *(const GAS f32x4*)(ssv + m * 8 + 4);
            const float rs = 1.0f / sqrtf((((p0[0] + p0[1]) + (p0[2] + p0[3])) + ((p1[0] + p1[1]) + (p1[2] + p1[3]))) * (1.0f / 512.0f) + EPS);
            const v4u raw = *(const GAS v4u*)(Z + m * DIN + ZG + 8 * cc);
            const f32x4 a = (f32x4){bf_lo(raw.x), bf_hi(raw.x), bf_lo(raw.y), bf_hi(raw.y)} * rs * gv0, c = (f32x4){bf_lo(raw.z), bf_hi(raw.z), bf_lo(raw.w), bf_hi(raw.w)} * rs * gv1;
            v4u pk; pk.x = cvtpk(a[0], a[1]); pk.y = cvtpk(a[2], a[3]); pk.z = cvtpk(c[0], c[1]); pk.w = cvtpk(c[2], c[3]);
            *(LAS v4u*)(Gl + sr * GVS + cc * 16) = pk;
            if (wout) { float* op = ogp + ((size_t)b * 128 + sr) * 512 + 8 * cc; *(GAS f32x4*)op = a; *(GAS f32x4*)(op + 4) = c; } }
    }
    __syncthreads();
    f32x4 y[4][4];
#pragma unroll
    for (int tf = 0; tf < 4; ++tf) {
        const int tc = 64 * half + 16 * tf + ql; const size_t mt = m0 + tc;
        const int nfr = 4 * half + tf + 1, npair = (nfr + 1) >> 1;
        f32x4 acc[4];
#pragma unroll
        for (int d0 = 0; d0 < 4; ++d0) acc[d0] = (f32x4){0.f, 0.f, 0.f, 0.f};
        const bf16* wrow = tril + ((size_t)w * 128 + tc) * 128 + 4 * g;
        LAS const unsigned char* gp = Gl + (4 * g + (ql >> 2)) * GVS + (w * 64 + 4 * (ql & 3)) * 2;
        for (int kk = 0; kk < npair; ++kk) { const int f0 = 2 * kk; const bool two = (2 * kk + 1 < nfr); const int f1 = two ? f0 + 1 : f0;
            v2u w0 = *(const GAS v2u*)(wrow + 16 * f0), w1 = *(const GAS v2u*)(wrow + 16 * f1); if (!two) w1 = (v2u){0u, 0u};
            const bf16x8 pb = __builtin_bit_cast(bf16x8, ((v4u){w0.x, w0.y, w1.x, w1.y}));
#pragma unroll
            for (int d0 = 0; d0 < 4; ++d0) { const s16x4 lo = vtr(gp + f0 * 16 * GVS + d0 * 32), hi = vtr(gp + f1 * 16 * GVS + d0 * 32);
                const bf16x8 va = (bf16x8){lo[0], lo[1], lo[2], lo[3], hi[0], hi[1], hi[2], hi[3]};
                acc[d0] = MFMA16(va, pb, acc[d0]); } }
        const float bias = F.in[13][w * 128 + tc]; float q = 0.f;
#pragma unroll
        for (int d0 = 0; d0 < 4; ++d0) { const v2u ur = *(const GAS v2u*)(Z + mt * DIN + ZU + w * 64 + 16 * d0 + 4 * g);
            const f32x4 uu = (f32x4){bf_lo(ur.x), bf_hi(ur.x), bf_lo(ur.y), bf_hi(ur.y)}; const f32x4 v = uu * (acc[d0] + bias); y[tf][d0] = v;
            q += (v[0] * v[0] + v[1] * v[1]) + (v[2] * v[2] + v[3] * v[3]); }
        q = xs4(q);
        if (g == 0) xch[(16 * tf + ql) * 8 + w] = q;
    }
    __syncthreads();
    const float* gg = F.in[15];
#pragma unroll
    for (int tf = 0; tf < 4; ++tf) {
        const f32x4 t0 = *(const LAS f32x4*)(xch + (16 * tf + ql) * 8), t1 = *(const LAS f32x4*)(xch + (16 * tf + ql) * 8 + 4);
        const float tot = ((t0[0] + t0[1]) + (t0[2] + t0[3])) + ((t1[0] + t1[1]) + (t1[2] + t1[3]));
        const float rg = 1.0f / sqrtf(tot * (1.0f / 512.0f) + EPS);
        const size_t mt = m0 + 64 * half + 16 * tf + ql;
#pragma unroll
        for (int d0 = 0; d0 < 4; ++d0) { const int col = w * 64 + 16 * d0 + 4 * g; const f32x4 gn = *(const GAS f32x4*)(gg + col); const f32x4 v = y[tf][d0] * rg * gn;
            v2u pk; pk.x = cvtpk(v[0], v[1]); pk.y = cvtpk(v[2], v[3]); *(GAS v2u*)(AO + mt * DM + 512 + col) = pk; }
    }
    __syncthreads();
}

__device__ __forceinline__ void p4_sample_unit(Frame& F, int b) {
    const bf16* Z = (const bf16*)(F.ws + WS_Z); bf16* AO = (bf16*)(F.ws + WS_AO); const float* ssv = (const float*)(F.ws + WS_SSV);
    LAS unsigned char* Kl = F.lds; LAS unsigned char* Vl = F.lds + 2 * 144 * KVS; LAS float* xch = (LAS float*)(F.lds + XCH_OFF); LAS float* xch2 = xch + 512;
    const int lane = F.lane, w = F.wave, g = lane >> 4, ql = lane & 15, tid = F.tid;
    const float* ck = F.in[2] + (size_t)b * 128 * 128; const float* cv = F.in[3] + (size_t)b * 128 * 128;
    float* oks = F.out + O_KS + (size_t)b * 128 * 128; float* ovs = F.out + O_VS + (size_t)b * 128 * 128;
    for (int i = tid; i < 128 * 32; i += NWAVES * 64) { const int jr = i >> 5, c = i & 31, kvh = c >> 4, d4 = (c & 15) * 4;
        const f32x4 vk = *(const GAS f32x4*)(ck + jr * 128 + c * 4), vv = *(const GAS f32x4*)(cv + jr * 128 + c * 4);
        v2u pk; pk.x = cvtpk(vk[0], vk[1]); pk.y = cvtpk(vk[2], vk[3]); *(LAS v2u*)(Kl + kvh * (144 * KVS) + jr * KVS + d4 * 2) = pk;
        v2u pv; pv.x = cvtpk(vv[0], vv[1]); pv.y = cvtpk(vv[2], vv[3]); *(LAS v2u*)(Vl + kvh * (144 * KVS) + jr * KVS + d4 * 2) = pv;
        if (jr >= 4) { *(GAS f32x4*)(oks + (jr - 4) * 128 + c * 4) = vk; *(GAS f32x4*)(ovs + (jr - 4) * 128 + c * 4) = vv; } }
    if (tid < 128) { const int t = tid >> 5, within = tid & 31;
        const v4u v = *(const GAS v4u*)(Z + (size_t)(MP + 4 * b + t) * DIN + ZK + within * 8);
        LAS unsigned char* dst = ((within & 16) ? Vl : Kl) + ((within >> 3) & 1) * (144 * KVS) + (128 + t) * KVS + (within & 7) * 16; *(LAS v4u*)dst = v; }
    else if (tid < 128 + 384) { const int e = tid - 128, r = e >> 5, within = e & 31;
        LAS unsigned char* dst = ((within & 16) ? Vl : Kl) + ((within >> 3) & 1) * (144 * KVS) + (132 + r) * KVS + (within & 7) * 16; *(LAS v4u*)dst = (v4u){0u, 0u, 0u, 0u}; }
    __syncthreads();
    f32x4 o[4]; const int t_q = ql & 3, hq = ql >> 2;
    if (w < 2) {
        const int h = 4 * w + hq; const size_t m = (size_t)MP + 4 * b + t_q; const float sink2 = F.in[10][h] * LOG2E_F;
        const bf16x8 qf0 = *(const GAS bf16x8*)(Z + m * DIN + ZQ + h * 64 + 8 * g), qf1 = *(const GAS bf16x8*)(Z + m * DIN + ZQ + h * 64 + 32 + 8 * g);
        attn_core<9>(o, qf0, qf1, Kl + w * (144 * KVS) + ql * KVS + 16 * g, Vl + w * (144 * KVS) + (4 * g + (ql >> 2)) * KVS + 8 * (ql & 3), 4 * g, t_q + 1, t_q + 128, sink2);
        float q = 0.f;
#pragma unroll
        for (int d0 = 0; d0 < 4; ++d0) q += (o[d0][0] * o[d0][0] + o[d0][1] * o[d0][1]) + (o[d0][2] * o[d0][2] + o[d0][3] * o[d0][3]);
        q = xs4(q); q += __shfl_xor(q, 4); q += __shfl_xor(q, 8);
        if (lane < 4) xch[lane * 8 + w] = q;
    }
    const int c = tid; float gvn[4], yg[4];
    {
        const float gvc = F.in[11][c]; float* ogs = F.out + O_GS + (size_t)b * 4 * 512;
#pragma unroll
        for (int s = 0; s < 4; ++s) { const size_t m = (size_t)MP + 4 * b + s;
            const f32x4 p0 = *(const GAS f32x4*)(ssv + m * 8), p1 = *(const GAS f32x4*)(ssv + m * 8 + 4);
            const float rs = 1.0f / sqrtf((((p0[0] + p0[1]) + (p0[2] + p0[3])) + ((p1[0] + p1[1]) + (p1[2] + p1[3]))) * (1.0f / 512.0f) + EPS);
            const float raw = __builtin_bit_cast(float, (unsigned)Z[m * DIN + ZG + c] << 16); gvn[s] = raw * rs * gvc; ogs[s * 512 + c] = gvn[s]; }
#pragma unroll
        for (int t = 0; t < 4; ++t) { const size_t m = (size_t)MP + 4 * b + t; float mix = F.in[13][w * 128 + t];
#pragma unroll
            for (int s = 0; s <= t; ++s) mix += F.in[12][((size_t)w * 128 + t) * 128 + s] * gvn[s];
            const float uu = __builtin_bit_cast(float, (unsigned)Z[m * DIN + ZU + c] << 16); yg[t] = uu * mix;
            const float q = wave_sum(yg[t] * yg[t]); if (lane == 0) xch2[t * 8 + w] = q; }
    }
    __syncthreads();
    if (w < 2) {
        const int h = 4 * w + hq; const size_t m = (size_t)MP + 4 * b + t_q;
        const float tot = xch[t_q * 8] + xch[t_q * 8 + 1]; const float ra = 1.0f / sqrtf(tot * (1.0f / 512.0f) + EPS);
#pragma unroll
        for (int d0 = 0; d0 < 4; ++d0) { const int col = h * 64 + 16 * d0 + 4 * g; const f32x4 gn = *(const GAS f32x4*)(F.in[14] + col); const f32x4 v = o[d0] * ra * gn;
            v2u pk; pk.x = cvtpk(v[0], v[1]); pk.y = cvtpk(v[2], v[3]); *(GAS v2u*)(AO + m * DM + col) = pk; }
    }
    {
        const float ggc = F.in[15][c];
#pragma unroll
        for (int t = 0; t < 4; ++t) { const size_t m = (size_t)MP + 4 * b + t; float tot = 0.f;
#pragma unroll
            for (int k = 0; k < 8; ++k) tot += xch2[t * 8 + k];
            const float rg = 1.0f / sqrtf(tot * (1.0f / 512.0f) + EPS); AO[m * DM + 512 + c] = (bf16)f2bf(yg[t] * rg * ggc); }
    }
    __syncthreads();
}

__device__ __forceinline__ void p8_final(Frame& F) {
    const int gw = F.vcu * NWAVES + F.wave, NGW = F.G * NWAVES; const float* ss3 = (const float*)(F.ws + WS_SS3); const GAS f32x4* gr = (const GAS f32x4*)F.in[21] + F.lane;
    f32x4 gn[4];
#pragma unroll
    for (int j = 0; j < 4; ++j) gn[j] = gr[64 * j];
    for (int m = gw; m < M; m += NGW) {
        const f32x4 p0 = *(const GAS f32x4*)(ss3 + (size_t)m * 16), p1 = *(const GAS f32x4*)(ss3 + (size_t)m * 16 + 4), p2 = *(const GAS f32x4*)(ss3 + (size_t)m * 16 + 8), p3 = *(const GAS f32x4*)(ss3 + (size_t)m * 16 + 12);
        const float tot = (((p0[0] + p0[1]) + (p0[2] + p0[3])) + ((p1[0] + p1[1]) + (p1[2] + p1[3]))) + (((p2[0] + p2[1]) + (p2[2] + p2[3])) + ((p3[0] + p3[1]) + (p3[2] + p3[3])));
        const float rs = 1.0f / sqrtf(tot * (1.0f / DM) + EPS);
        GAS f32x4* xr = (GAS f32x4*)(F.out + (size_t)m * DM) + F.lane;
#pragma unroll
        for (int j = 0; j < 4; ++j) xr[64 * j] = xr[64 * j] * rs * gn[j];
    }
}

struct Args { const float* in[22]; float* out; unsigned char* ws; int ph_lo, ph_hi, li, pad; };
__global__ void __launch_bounds__(NWAVES * 64, 2) mk_fwd(Args args) {
    extern __shared__ __attribute__((aligned(16))) unsigned char lds[];
    Frame F;
    F.lds = (LAS unsigned char*)lds;
    F.MISC = (volatile LAS unsigned*)(F.lds + MISC_OFF);
    F.tid = threadIdx.x; F.lane = F.tid & 63; F.wave = __builtin_amdgcn_readfirstlane(F.tid >> 6);
    F.G = gridDim.x; { const int bx = blockIdx.x; F.vcu = (F.G % 8 == 0) ? (bx % 8) * (F.G / 8) + bx / 8 : bx; }
    unsigned char* ws = args.ws; F.ws = ws; F.out = args.out;
    F.ctl = (gu32*)(ws + WS_CTL);
#pragma unroll
    for (int i = 0; i < 22; ++i) F.in[i] = args.in[i];
    for (int u = F.tid; u < (LDS_BYTES - LDSCTL_OFF) / 4; u += NWAVES * 64) ((LAS unsigned*)(F.lds + LDSCTL_OFF))[u] = 0u;
    __syncthreads();
    XcdBarrier bar; bar.bar = (unsigned*)(F.ctl + CW_BAR); bar.x = 0; bar.st = nullptr;
    if (N_LAUNCHES == 1) bar = xcd_barrier_post((unsigned*)(F.ctl + CW_BAR), F.MISC + 8);
#define GRID_BAR() do { if (N_LAUNCHES == 1) xcd_barrier(bar); } while (0)
    const int lo = args.ph_lo, hi = args.ph_hi;
#define IN(k) (lo <= (k) && (k) < hi)
#define BOTH(k) (IN(k) && IN((k) + 1))
    bf16* XB = (bf16*)(ws + WS_XB); bf16* HB = (bf16*)(ws + WS_H); bf16* ZB = (bf16*)(ws + WS_Z); bf16* AO = (bf16*)(ws + WS_AO);
    float* SS1 = (float*)(ws + WS_SS1); float* SS2 = (float*)(ws + WS_SS2); float* SS3 = (float*)(ws + WS_SS3); float* SSV = (float*)(ws + WS_SSV);
    float* X = F.out + O_Y;

    if (IN(0)) { p0_prologue(F); if (BOTH(0)) GRID_BAR(); }
    if (IN(1)) {
        pg8::Gemm g{XB, (const bf16*)(ws + WS_WGU1), M, NGU, DM}; pg8::StaticOrder S; S.init(M, NGU, F.G, (int)blockIdx.x);
        pg8::EpiSwiGLU<false> E{HB, FF, nullptr};
        pg8::gemm_phase<pg8::EpiSwiGLU<false>, pg8::StaticOrder, PG8_ALIGN, PG8_SP2>(F.lds + RING_OFF, g, S, E);
        if (BOTH(1)) GRID_BAR();
    }
    if (IN(2)) {
        pg8::Gemm g{HB, (const bf16*)(ws + WS_WD1), MP, DM, FF}; pg8::StaticOrder S; S.init(MP, DM, F.G, (int)blockIdx.x);
        pg8::EpiRes<true> E{F.in[0], F.in[1] - (size_t)MP * DM, MP / 256, X, XB, SS1, 0.5f};
        pg8::gemm_phase<pg8::EpiRes<true>, pg8::StaticOrder, PG8_ALIGN, PG8_SP2>(F.lds + RING_OFF, g, S, E);
        for (int t = F.vcu; t < 256; t += F.G) mini_gemm<FF>(F.lds + RING_OFF, HB + (size_t)MP * FF, (const bf16*)(ws + WS_WD1), MP, t, E, F.tid, F.wave, F.lane);
        if (BOTH(2)) GRID_BAR();
    }
    if (IN(3)) {
        pg8::Gemm g{XB, (const bf16*)(ws + WS_WIN), M, DIN, DM}; pg8::StaticOrder S; S.init(M, DIN, F.G, (int)blockIdx.x);
        pg8::EpiInProj E{ZB, SS1, (const float*)(ws + WS_ROPE), SSV, F.out, (long)O_KP, (long)O_KS, (long)(O_VP - O_KP), (long)(O_VS - O_KS)};
        pg8::gemm_phase<pg8::EpiInProj, pg8::StaticOrder, PG8_ALIGN, PG8_SP2>(F.lds + RING_OFF, g, S, E);
        if (BOTH(3)) GRID_BAR();
    }
    if (IN(4)) {
        for (int u = F.vcu; u < 128; u += F.G) p4_sample_unit(F, u);
        for (int u = F.vcu; u < 256; u += F.G) p4_attn_unit(F, u >> 6, u & 63);
        for (int u = F.vcu; u < 256; u += F.G) p4_gmlp_unit(F, u >> 6, u & 63);
        if (BOTH(4)) GRID_BAR();
    }
    if (IN(5)) {
        pg8::Gemm g{AO, (const bf16*)(ws + WS_WOUT), MP, DM, DM}; pg8::StaticOrder S; S.init(MP, DM, F.G, (int)blockIdx.x);
        pg8::EpiRes<true> E{X, X, 1 << 30, X, XB, SS2, 1.0f};
        pg8::gemm_phase<pg8::EpiRes<true>, pg8::StaticOrder, PG8_ALIGN, PG8_SP2>(F.lds + RING_OFF, g, S, E);
        for (int t = F.vcu; t < 256; t += F.G) mini_gemm<DM>(F.lds + RING_OFF, AO + (size_t)MP * DM, (const bf16*)(ws + WS_WOUT), MP, t, E, F.tid, F.wave, F.lane);
        if (BOTH(5)) GRID_BAR();
    }
    if (IN(6)) {
        pg8::Gemm g{XB, (const bf16*)(ws + WS_WGU2), M, NGU, DM}; pg8::StaticOrder S; S.init(M, NGU, F.G, (int)blockIdx.x);
        pg8::EpiSwiGLU<true> E{HB, FF, SS2};
        pg8::gemm_phase<pg8::EpiSwiGLU<true>, pg8::StaticOrder, PG8_ALIGN, PG8_SP2>(F.lds + RING_OFF, g, S, E);
        if (BOTH(6)) GRID_BAR();
    }
    if (IN(7)) {
        pg8::Gemm g{HB, (const bf16*)(ws + WS_WD2), MP, DM, FF}; pg8::StaticOrder S; S.init(MP, DM, F.G, (int)blockIdx.x);
        pg8::EpiRes<false> E{X, X, 1 << 30, X, nullptr, SS3, 0.5f};
        pg8::gemm_phase<pg8::EpiRes<false>, pg8::StaticOrder, PG8_ALIGN, PG8_SP2>(F.lds + RING_OFF, g, S, E);
        for (int t = F.vcu; t < 256; t += F.G) mini_gemm<FF>(F.lds + RING_OFF, HB + (size_t)MP * FF, (const bf16*)(ws + WS_WD2), MP, t, E, F.tid, F.wave, F.lane);
        if (BOTH(7)) GRID_BAR();
    }
    if (IN(8)) p8_final(F);
#undef IN
#undef BOTH
}

extern "C" void kernel_launch(void* const* d_in, const int* in_sizes, int n_in, void* d_out, int out_size, void* d_ws, size_t ws_size, hipStream_t stream) {
    static int grid = 0;
    if (grid == 0) {
        if (n_in != 22 || in_sizes[0] != MP * DM || out_size != (int)O_END || ws_size < WS_END) { fprintf(stderr, "kernel_launch: unexpected shapes (n_in %d, in0 %d, out %d, ws %zu); nothing launched\n", n_in, n_in > 0 ? in_sizes[0] : -1, out_size, ws_size); grid = -1; return; }
        int dev = 0, cus = 0, per_cu = 0;
        if (hipGetDevice(&dev) != hipSuccess || hipDeviceGetAttribute(&cus, hipDeviceAttributeMultiprocessorCount, dev) != hipSuccess) { fprintf(stderr, "kernel_launch: device query failed\n"); grid = -1; return; }
        if (hipFuncSetAttribute((const void*)mk_fwd, hipFuncAttributeMaxDynamicSharedMemorySize, LDS_BYTES) != hipSuccess) { fprintf(stderr, "kernel_launch: hipFuncSetAttribute failed\n"); grid = -1; return; }
        if (hipOccupancyMaxActiveBlocksPerMultiprocessor(&per_cu, (const void*)mk_fwd, NWAVES * 64, LDS_BYTES) != hipSuccess || per_cu < 1) { fprintf(stderr, "kernel_launch: occupancy query reports %d workgroups per CU\n", per_cu); grid = -1; (void)hipGetLastError(); return; }
        (void)hipGetLastError();
        grid = cus;
    }
    if (grid < 0) return;
    if (hipMemsetAsync((char*)d_ws + WS_CTL, 0, CTL_ZERO_BYTES, stream) != hipSuccess) { fprintf(stderr, "kernel_launch: hipMemsetAsync failed\n"); return; }
    Args a{};
    for (int i = 0; i < 22; ++i) a.in[i] = (const float*)d_in[i];
    a.out = (float*)d_out; a.ws = (unsigned char*)d_ws;
    for (int li = 0; li < N_LAUNCHES; ++li) {
        a.ph_lo = (N_LAUNCHES == 1) ? 0 : li; a.ph_hi = (N_LAUNCHES == 1) ? N_PHASES : li + 1; a.li = li;
        hipLaunchKernelGGL(mk_fwd, dim3(grid), dim3(NWAVES * 64), LDS_BYTES, stream, a);
        const hipError_t le = hipPeekAtLastError();
        if (le != hipSuccess) { fprintf(stderr, "kernel_launch: launch %d failed: %s\n", li, hipGetErrorName(le)); break; }
    }
}
```

```cpp
#include <hip/hip_runtime.h>
#include <cstdio>
#include <cstdint>
#include <cmath>
namespace pg8 {
#define PG8_LAS __attribute__((address_space(3)))
typedef unsigned short bf16_t;
typedef short bf16x8 __attribute__((ext_vector_type(8)));
typedef float f32x4 __attribute__((ext_vector_type(4)));
typedef unsigned u32x4 __attribute__((ext_vector_type(4)));
constexpr int BM = 256, BK = 64, HALF = 128, HTB = HALF * BK * 2  , STAGE_BYTES = 8 * HTB, NXCD = 8, WGM = 8;

__host__ __device__ __forceinline__ int lds_byte(int r, int c) { const int st = (r >> 4) * 2 + (c >> 5), rr = r & 15, cc = c & 31, ob = rr * 64 + cc * 2; return st * 1024 + (ob ^ (((ob >> 9) & 1) << 5)); }
__host__ __device__ __forceinline__ void stage_rc(int b, int& R, int& C) { const int st = b / 1024, sb = b % 1024, swz = sb ^ (((sb >> 9) & 1) << 5); R = (st >> 1) * 16 + swz / 64; C = (st & 1) * 32 + (swz % 64) / 2; }
__host__ __device__ __forceinline__ int perm32(int rho) { const int n = rho >> 4, i = rho & 15; return 8 * (i >> 2) + 4 * n + (i & 3); }

struct Unit { int pm, pn; };
struct Gemm { const bf16_t* A; const bf16_t* Bt; int M, N, K; };

struct StaticOrder {
    int nM, nN, nwg, G, c;
    __host__ __device__ void init(int M, int N, int G_, int c_) { nM = M / BM; nN = N / BM; nwg = nM * nN; G = G_; c = c_; }
    __host__ __device__ bool next(int i, Unit& u) const {
        const long L = (long)i * G + c; if (L >= nwg) return false;
        int wgid = (int)L; { const int q = nwg / NXCD, r = nwg % NXCD, xcd = wgid % NXCD, off = wgid / NXCD; wgid = (xcd < r ? xcd * (q + 1) : r * (q + 1) + (xcd - r) * q) + off; }
        const int nig = WGM * nN, gid = wgid / nig, fm = gid * WGM, gsz = (nM - fm) < WGM ? (nM - fm) : WGM;
        u.pm = fm + ((wgid % nig) % gsz); u.pn = (wgid % nig) / gsz; return true;
    }
    __device__ __forceinline__ void a_ready(const Unit&) const {}
    __device__ __forceinline__ void done(const Unit&) const {}
};

__device__ __forceinline__ unsigned cvt_pk_bf16(float lo, float hi) { unsigned r; asm volatile("v_cvt_pk_bf16_f32 %0, %1, %2" : "=v"(r) : "v"(lo), "v"(hi)); return r; }
typedef float f32x2 __attribute__((ext_vector_type(2)));
constexpr float LOG2E = 1.4426950408889634f;
constexpr float RMS_EPS = 1e-6f;
__device__ __forceinline__ float xsum4(float s) { s += __shfl_xor(s, 16); s += __shfl_xor(s, 32); return s; }
__device__ __forceinline__ float row_rscale16(const float* ss, int row, int fq) {
    const f32x4 v = *(const f32x4*)(ss + (size_t)row * 16 + 4 * fq);
    const float s = xsum4((v[0] + v[1]) + (v[2] + v[3]));
    return __builtin_amdgcn_rsqf(s * (1.0f / 1024.0f) + RMS_EPS);
}
__device__ __forceinline__ float silu_mul(float g, float u) { return g * u * __builtin_amdgcn_rcpf(1.0f + __builtin_amdgcn_exp2f(-LOG2E * g)); }
__device__ __forceinline__ float gelu_tanh(float x) {
    const float t = x * (1.0f + 0.044715f * x * x);
    return x * __builtin_amdgcn_rcpf(1.0f + __builtin_amdgcn_exp2f(-2.0f * 0.7978845608028654f * LOG2E * t));
}
__device__ __forceinline__ u32x4 pack8(const f32x4& a, const f32x4& b) { u32x4 w; w.x = cvt_pk_bf16(a[0], a[1]); w.y = cvt_pk_bf16(a[2], a[3]); w.z = cvt_pk_bf16(b[0], b[1]); w.w = cvt_pk_bf16(b[2], b[3]); return w; }

template <bool SCALED> struct EpiSwiGLU {
    static constexpr bool PERM = true, AFTER_DRAIN = false;
    bf16_t* H; int ldh; const float* ss;
    __device__ __forceinline__ void operator()(const f32x4 (&acc)[2][2][4][2], const Unit& u, int wr, int wc, int fr, int fq) const {
        const int row0 = u.pm * BM + wr * 64 + fr, col0 = u.pn * HALF + wc * 32 + 8 * fq;
        float rsv[2][4];
#pragma unroll
        for (int ai = 0; ai < 2; ++ai)
#pragma unroll
            for (int m = 0; m < 4; ++m) rsv[ai][m] = SCALED ? row_rscale16(ss, row0 + ai * HALF + m * 16, fq) : 1.0f;
#pragma unroll
        for (int ai = 0; ai < 2; ++ai)
#pragma unroll
            for (int m = 0; m < 4; ++m) { const int row = row0 + ai * HALF + m * 16;
                const float rs = rsv[ai][m];
                f32x4 h[2];
#pragma unroll
                for (int n = 0; n < 2; ++n) { const f32x4 g = acc[ai][0][m][n] * rs, v = acc[ai][1][m][n] * rs;
#pragma unroll
                    for (int i = 0; i < 4; ++i) h[n][i] = silu_mul(g[i], v[i]); }
                *(u32x4*)(H + (size_t)row * ldh + col0) = pack8(h[0], h[1]); }
    }
};

template <int RES, bool WX, bool WB> struct EpiRes {
    static constexpr bool PERM = true, AFTER_DRAIN = false;
    const float* res_p; const float* res_s;
    int split_pm; float* X; bf16_t* XB; float* ss; float scale;
    __device__ __forceinline__ float apply4(int row, int col, const f32x4& v) const {
        typedef unsigned u32x2_ __attribute__((ext_vector_type(2)));
        const size_t off = (size_t)row * 1024 + col; f32x4 r;
        if (RES == 0) r = *(const f32x4*)(res_s + off);
        else { const u32x2_ w = *(const u32x2_*)(XB + off); r = (f32x4){__builtin_bit_cast(float, w.x << 16), __builtin_bit_cast(float, w.x & 0xffff0000u), __builtin_bit_cast(float, w.y << 16), __builtin_bit_cast(float, w.y & 0xffff0000u)}; }
        const f32x4 o = r + v * scale;
        if (WX) *(f32x4*)(X + off) = o;
        if (WB) { u32x2_ w; w.x = cvt_pk_bf16(o[0], o[1]); w.y = cvt_pk_bf16(o[2], o[3]); *(u32x2_*)(XB + off) = w; }
        return (o[0] * o[0] + o[1] * o[1]) + (o[2] * o[2] + o[3] * o[3]);
    }
    __device__ __forceinline__ void operator()(const f32x4 (&acc)[2][2][4][2], const Unit& u, int wr, int wc, int fr, int fq) const {
        const int row0 = u.pm * BM + wr * 64 + fr, col0 = u.pn * BM + wc * 32 + 8 * fq;
        const float* rb = (u.pm < split_pm) ? res_p : res_s;
#pragma unroll
        for (int ai = 0; ai < 2; ++ai)
#pragma unroll
            for (int m = 0; m < 4; ++m) { const int row = row0 + ai * HALF + m * 16; const size_t off = (size_t)row * 1024 + col0; float q = 0.f;
#pragma unroll
                for (int bj = 0; bj < 2; ++bj) {
                    f32x4 r0, r1;
                    if (RES == 0) { r0 = *(const f32x4*)(rb + off + bj * HALF); r1 = *(const f32x4*)(rb + off + bj * HALF + 4); }
                    else { const u32x4 w = *(const u32x4*)(XB + off + bj * HALF);
                        r0 = (f32x4){__builtin_bit_cast(float, w.x << 16), __builtin_bit_cast(float, w.x & 0xffff0000u), __builtin_bit_cast(float, w.y << 16), __builtin_bit_cast(float, w.y & 0xffff0000u)};
                        r1 = (f32x4){__builtin_bit_cast(float, w.z << 16), __builtin_bit_cast(float, w.z & 0xffff0000u), __builtin_bit_cast(float, w.w << 16), __builtin_bit_cast(float, w.w & 0xffff0000u)}; }
                    const f32x4 o0 = r0 + acc[ai][bj][m][0] * scale, o1 = r1 + acc[ai][bj][m][1] * scale;
                    q += (o0[0] * o0[0] + o0[1] * o0[1]) + (o0[2] * o0[2] + o0[3] * o0[3]); q += (o1[0] * o1[0] + o1[1] * o1[1]) + (o1[2] * o1[2] + o1[3] * o1[3]);
                    if (WX) { *(f32x4*)(X + off + bj * HALF) = o0; *(f32x4*)(X + off + bj * HALF + 4) = o1; }
                    if (WB) *(u32x4*)(XB + off + bj * HALF) = pack8(o0, o1); }
                q = xsum4(q);
                if (fq == 0) ss[(size_t)row * 16 + u.pn * 4 + wc] = q; }
    }
};

struct EpiInProj {
    static constexpr bool PERM = true, AFTER_DRAIN = false;
    bf16_t* Z; const float* ss1; const float* rope; float* ssv; float* outb; long o_kp, o_ks, d_p, d_s;
    __device__ __forceinline__ void operator()(const f32x4 (&acc)[2][2][4][2], const Unit& u, int wr, int wc, int fr, int fq) const {
        const int row0 = u.pm * BM + wr * 64 + fr, pn = u.pn, cb = pn * BM + wc * 64 + 8 * fq;
        const bool rot = (pn < 2) || (pn == 2 && wc < 2);
        float rsv[2][4];
#pragma unroll
        for (int ai = 0; ai < 2; ++ai)
#pragma unroll
            for (int m = 0; m < 4; ++m) rsv[ai][m] = row_rscale16(ss1, row0 + ai * HALF + m * 16, fq);
#pragma unroll
        for (int ai = 0; ai < 2; ++ai)
#pragma unroll
            for (int m = 0; m < 4; ++m) { const int row = row0 + ai * HALF + m * 16;
                const float rs = rsv[ai][m];
                f32x4 a0 = acc[ai][0][m][0] * rs, a1 = acc[ai][0][m][1] * rs, b0 = acc[ai][1][m][0] * rs, b1 = acc[ai][1][m][1] * rs;
                if (rot) {
                    const int pi = (row < 16384) ? (row & 4095) : (4096 + (row & 3));
                    const float* ct = rope + (size_t)pi * 64 + 8 * fq;
                    const f32x4 c0 = *(const f32x4*)(ct), c1 = *(const f32x4*)(ct + 4), s0 = *(const f32x4*)(ct + 32), s1 = *(const f32x4*)(ct + 36);
                    const f32x4 x0 = a0 * c0 - b0 * s0, x1 = a1 * c1 - b1 * s1, y0 = b0 * c0 + a0 * s0, y1 = b1 * c1 + a1 * s1;
                    a0 = x0; a1 = x1; b0 = y0; b1 = y1;
                    if (pn < 2) { const float qs = 0.125f * LOG2E; a0 = a0 * qs; a1 = a1 * qs; b0 = b0 * qs; b1 = b1 * qs; }
                } else if (pn >= 3) {
#pragma unroll
                    for (int i = 0; i < 4; ++i) { a0[i] = gelu_tanh(a0[i]); a1[i] = gelu_tanh(a1[i]); b0[i] = gelu_tanh(b0[i]); b1[i] = gelu_tanh(b1[i]); }
                    if (pn >= 5) {
                        float q = (a0[0] * a0[0] + a0[1] * a0[1]) + (a0[2] * a0[2] + a0[3] * a0[3]); q += (a1[0] * a1[0] + a1[1] * a1[1]) + (a1[2] * a1[2] + a1[3] * a1[3]);
                        q += (b0[0] * b0[0] + b0[1] * b0[1]) + (b0[2] * b0[2] + b0[3] * b0[3]); q += (b1[0] * b1[0] + b1[1] * b1[1]) + (b1[2] * b1[2] + b1[3] * b1[3]);
                        q = xsum4(q);
                        if (fq == 0) ssv[(size_t)row * 8 + (pn - 5) * 4 + wc] = q; }
                }
                if (pn == 2) {
                    const bool smp = (u.pm >= 64); float* ob = outb + (smp ? o_ks : o_kp) + ((wc >= 2) ? (smp ? d_s : d_p) : 0); const int kvh = wc & 1; bool wr_ = false; size_t o = 0;
                    if (u.pm >= 64) { const int bs = (row - 16384) >> 2, t = row & 3; o = ((size_t)(bs * 128 + 124 + t) * 2 + kvh) * 64 + 8 * fq; wr_ = true; }
                    else if ((u.pm & 15) == 15 && ai == 1) { const int bp = row >> 12, t = (row & 4095) - 3968; o = ((size_t)(bp * 128 + t) * 2 + kvh) * 64 + 8 * fq; wr_ = true; }
                    if (wr_) { *(f32x4*)(ob + o) = a0; *(f32x4*)(ob + o + 4) = a1; *(f32x4*)(ob + o + 32) = b0; *(f32x4*)(ob + o + 36) = b1; }
                }
                bf16_t* zr = Z + (size_t)row * 1792 + cb;
                *(u32x4*)(zr) = pack8(a0, a1); *(u32x4*)(zr + 32) = pack8(b0, b1); }
    }
};
template <class Epi, class Sched, bool ALIGN_EPI = false, bool SP2 = false>
__device__ __forceinline__ void gemm_phase(PG8_LAS unsigned char* lds, const Gemm g, const Sched& S, const Epi& E) {
    const int tid = threadIdx.x, wid = __builtin_amdgcn_readfirstlane(tid >> 6), lane = tid & 63, wr = wid >> 2, wc = wid & 3, fr = lane & 15, fq = lane >> 4;
    const int K = g.K, nt = K / BK;
    unsigned voffA[2], voffB[2];
#pragma unroll
    for (int i = 0; i < 2; ++i) { int R, C; stage_rc(tid * 16 + i * 8192, R, C); const int Rb = Epi::PERM ? ((R & ~31) + perm32(R & 31)) : R;
        voffA[i] = (unsigned)(R * K + C) * 2u; voffB[i] = (unsigned)(Rb * K + C) * 2u; }
    const size_t kstep = (size_t)(BK * 2);
    const size_t hstep = (size_t)HALF * K * 2;
    const size_t tstep = 2 * hstep;
    const unsigned ldsw = (unsigned)wid * 1024u;
    const int aoff = lds_byte(wr * 64 + fr, fq * 8), boff = lds_byte(wc * 32 + fr, fq * 8);
#define PG8_SA(b, h) (((b) * 2 + (h)) * HTB)
#define PG8_SB(b, h) ((4 + (b) * 2 + (h)) * HTB)
#define PG8_STAGE(bufoff, gbase, voff) do { _Pragma("unroll") for (int _i = 0; _i < 2; ++_i) \
        __builtin_amdgcn_global_load_lds((const unsigned*)((const char*)(gbase) + (voff)[_i]), (PG8_LAS unsigned*)(lds + (bufoff) + ldsw + _i * 8192), 16, 0, 0); } while (0)
#define PG8_LDA(dst, b, h) do { _Pragma("unroll") for (int m = 0; m < 4; ++m) _Pragma("unroll") for (int k = 0; k < 2; ++k) dst[m][k] = *(const PG8_LAS bf16x8*)(lds + PG8_SA(b, h) + aoff + m * 2048 + k * 1024); } while (0)
#define PG8_LDB(dst, b, h) do { _Pragma("unroll") for (int n = 0; n < 2; ++n) _Pragma("unroll") for (int k = 0; k < 2; ++k) dst[n][k] = *(const PG8_LAS bf16x8*)(lds + PG8_SB(b, h) + boff + n * 2048 + k * 1024); } while (0)
#define PG8_MMA(ai, bj, At, Bt) do { __builtin_amdgcn_s_setprio(1); _Pragma("unroll") for (int m = 0; m < 4; ++m) _Pragma("unroll") for (int n = 0; n < 2; ++n) _Pragma("unroll") for (int k = 0; k < 2; ++k) \
        acc[ai][bj][m][n] = __builtin_amdgcn_mfma_f32_16x16x32_bf16(Bt[n][k], At[m][k], acc[ai][bj][m][n], 0, 0, 0); __builtin_amdgcn_s_setprio(0); } while (0)
#define PG8_WAIT_V(n) asm volatile("s_waitcnt vmcnt(" #n ")" ::: "memory")
#define PG8_WAIT_L(n) asm volatile("s_waitcnt lgkmcnt(" #n ")" ::: "memory")
#define PG8_BAR __builtin_amdgcn_s_barrier()
#define PG8_SCHED __builtin_amdgcn_sched_barrier(0)
    Unit cur, nxt; int ui = 0;
    if (!S.next(0, cur)) return;
    f32x4 acc[2][2][4][2];
#pragma unroll
    for (int a = 0; a < 2; ++a)
#pragma unroll
        for (int b = 0; b < 2; ++b)
#pragma unroll
            for (int m = 0; m < 4; ++m)
#pragma unroll
                for (int n = 0; n < 2; ++n) acc[a][b][m][n] = (f32x4){0.f, 0.f, 0.f, 0.f};
    bf16x8 At[4][2], B0[2][2], B1[2][2];
    const char* cA = (const char*)g.A + (size_t)cur.pm * tstep; const char* cB = (const char*)g.Bt + (size_t)cur.pn * tstep;
    S.a_ready(cur);
    if constexpr (SP2) {
        PG8_STAGE(PG8_SB(0, 0), cB, voffB); PG8_STAGE(PG8_SB(0, 1), cB + hstep, voffB); PG8_STAGE(PG8_SA(0, 0), cA, voffA); PG8_STAGE(PG8_SA(0, 1), cA + hstep, voffA);
        if (wr == 1) PG8_BAR;
        PG8_WAIT_V(2); PG8_BAR;
        PG8_STAGE(PG8_SB(1, 0), cB + kstep, voffB); PG8_STAGE(PG8_SA(1, 0), cA + kstep, voffA); PG8_STAGE(PG8_SB(1, 1), cB + hstep + kstep, voffB);
        PG8_WAIT_V(6); PG8_BAR;
    } else {
        PG8_STAGE(PG8_SB(0, 0), cB, voffB); PG8_STAGE(PG8_SA(0, 0), cA, voffA); PG8_STAGE(PG8_SB(0, 1), cB + hstep, voffB); PG8_STAGE(PG8_SA(0, 1), cA + hstep, voffA);
        if (wr == 1) PG8_BAR;
        PG8_WAIT_V(4); PG8_BAR;
        PG8_STAGE(PG8_SB(1, 0), cB + kstep, voffB); PG8_STAGE(PG8_SA(1, 0), cA + kstep, voffA); PG8_STAGE(PG8_SB(1, 1), cB + hstep + kstep, voffB);
        PG8_WAIT_V(6); PG8_BAR;
    }
    for (;;) {
        const bool has_next = S.next(ui + 1, nxt);
        const char* nA = has_next ? (const char*)g.A + (size_t)nxt.pm * tstep : cA; const char* nB = has_next ? (const char*)g.Bt + (size_t)nxt.pn * tstep : cB;
        for (int t = 0; t < nt; t += 2) {
            const bool last = (t == nt - 2);
            const char* a1 = cA + (size_t)(t + 1) * kstep;
            const char* a2 = last ? nA : cA + (size_t)(t + 2) * kstep; const char* b2 = last ? nB : cB + (size_t)(t + 2) * kstep;
            const char* a3 = a2 + kstep; const char* b3 = b2 + kstep;
            if (last && has_next) S.a_ready(nxt);
            if constexpr (SP2) {
            PG8_LDB(B0, 0, 0); PG8_LDB(B1, 0, 1); PG8_SCHED; PG8_LDA(At, 0, 0); PG8_STAGE(PG8_SA(1, 1), a1 + hstep, voffA);
            PG8_WAIT_V(8); PG8_WAIT_L(0); PG8_BAR; PG8_MMA(0, 0, At, B0); PG8_MMA(0, 1, At, B1); PG8_BAR; PG8_SCHED;
            PG8_LDA(At, 0, 1); PG8_STAGE(PG8_SB(0, 0), b2, voffB); PG8_STAGE(PG8_SB(0, 1), b2 + hstep, voffB); PG8_STAGE(PG8_SA(0, 0), a2, voffA);
            PG8_WAIT_V(8); PG8_WAIT_L(0); PG8_BAR; PG8_MMA(1, 0, At, B0); PG8_MMA(1, 1, At, B1); PG8_BAR; PG8_SCHED;
            PG8_LDB(B0, 1, 0); PG8_LDB(B1, 1, 1); PG8_SCHED; PG8_LDA(At, 1, 0); PG8_STAGE(PG8_SA(0, 1), a2 + hstep, voffA);
            PG8_WAIT_V(8); PG8_WAIT_L(0); PG8_BAR; PG8_MMA(0, 0, At, B0); PG8_MMA(0, 1, At, B1); PG8_BAR; PG8_SCHED;
            PG8_LDA(At, 1, 1); PG8_STAGE(PG8_SB(1, 0), b3, voffB); PG8_STAGE(PG8_SB(1, 1), b3 + hstep, voffB); PG8_STAGE(PG8_SA(1, 0), a3, voffA);
            PG8_WAIT_V(8); PG8_WAIT_L(0); PG8_BAR; PG8_MMA(1, 0, At, B0); PG8_MMA(1, 1, At, B1); PG8_BAR; PG8_SCHED;
            } else {
            PG8_LDB(B0, 0, 0); PG8_SCHED; PG8_LDA(At, 0, 0); PG8_STAGE(PG8_SA(1, 1), a1 + hstep, voffA);
            PG8_WAIT_L(8); PG8_BAR; PG8_WAIT_L(0); PG8_MMA(0, 0, At, B0); PG8_BAR; PG8_SCHED;
            PG8_LDB(B1, 0, 1); PG8_STAGE(PG8_SB(0, 0), b2, voffB);
            PG8_BAR; PG8_WAIT_L(0); PG8_MMA(0, 1, At, B1); PG8_BAR;
            PG8_LDA(At, 0, 1); PG8_STAGE(PG8_SA(0, 0), a2, voffA);
            PG8_BAR; PG8_WAIT_L(0); PG8_MMA(1, 0, At, B0); PG8_BAR; PG8_SCHED;
            PG8_STAGE(PG8_SB(0, 1), b2 + hstep, voffB);
            PG8_WAIT_V(6); PG8_BAR; PG8_MMA(1, 1, At, B1); PG8_BAR;
            PG8_LDB(B0, 1, 0); PG8_SCHED; PG8_LDA(At, 1, 0); PG8_STAGE(PG8_SA(0, 1), a2 + hstep, voffA);
            PG8_WAIT_L(8); PG8_BAR; PG8_WAIT_L(0); PG8_MMA(0, 0, At, B0); PG8_BAR; PG8_SCHED;
            PG8_LDB(B1, 1, 1); PG8_STAGE(PG8_SB(1, 0), b3, voffB);
            PG8_BAR; PG8_WAIT_L(0); PG8_MMA(0, 1, At, B1); PG8_BAR;
            PG8_LDA(At, 1, 1); PG8_STAGE(PG8_SA(1, 0), a3, voffA);
            PG8_BAR; PG8_WAIT_L(0); PG8_MMA(1, 0, At, B0); PG8_BAR; PG8_SCHED;
            PG8_STAGE(PG8_SB(1, 1), b3 + hstep, voffB);
            PG8_WAIT_V(6); PG8_BAR; PG8_MMA(1, 1, At, B1); PG8_BAR;
            }
        }
        if constexpr (ALIGN_EPI) { if (wr == 0) PG8_BAR; }
#if PROBE == 4
        if constexpr (!Epi::AFTER_DRAIN) { E(acc, cur, wr, wc, fr, fq); asm volatile("" ::: "memory"); }
#endif
        if constexpr (!Epi::AFTER_DRAIN) { E(acc, cur, wr, wc, fr, fq); S.done(cur); }
        if (!has_next) break;
#pragma unroll
        for (int a = 0; a < 2; ++a)
#pragma unroll
            for (int b = 0; b < 2; ++b)
#pragma unroll
                for (int m = 0; m < 4; ++m)
#pragma unroll
                    for (int n = 0; n < 2; ++n) acc[a][b][m][n] = (f32x4){0.f, 0.f, 0.f, 0.f};
        cur = nxt; cA = nA; cB = nB; ++ui;
        if constexpr (ALIGN_EPI) { if (wr == 1) PG8_BAR; }
    }
    PG8_WAIT_V(0);
    if constexpr (!ALIGN_EPI) { if (wr == 0) PG8_BAR; }
    PG8_BAR;
    if constexpr (Epi::AFTER_DRAIN) { E.fused(acc, cur, wr, wc, fr, fq, lds, wid, lane); S.done(cur); }
#undef PG8_SA
#undef PG8_SB
#undef PG8_STAGE
#undef PG8_LDA
#undef PG8_LDB
#undef PG8_MMA
#undef PG8_WAIT_V
#undef PG8_WAIT_L
#undef PG8_BAR
#undef PG8_SCHED
}
}

#ifndef PROBE
#define PROBE 0
#endif
#ifndef PG8_SP2
#define PG8_SP2 true
#endif
#ifndef PG8_ALIGN
#define PG8_ALIGN true
#endif
#ifndef MK_N_LAUNCHES
#define MK_N_LAUNCHES 1
#endif
constexpr int NWAVES = 8;
constexpr int N_PHASES = 9;
constexpr int N_LAUNCHES = MK_N_LAUNCHES;
constexpr int DM = 1024, FF = 2816, NGU = 2 * FF, DIN = 1792;
constexpr int MP = 16384, MS = 512, M = MP + MS;
constexpr int ZQ = 0, ZK = 512, ZV = 640, ZU = 768, ZG = 1280;
constexpr float EPS = 1e-6f, LOG2E_F = 1.4426950408889634f;
constexpr size_t O_Y = 0, O_KP = 17301504, O_VP = 17367040, O_KS = 17432576, O_VS = 19529728, O_GP = 21626880, O_GS = 21889024, O_END = 22151168;
constexpr size_t MiB = 1u << 20;
constexpr size_t WS_CTL = 0, CTL_ZERO_BYTES = 1 * MiB;
constexpr size_t WS_WGU1 = 1 * MiB, WS_WD1 = 12 * MiB, WS_WIN = 18 * MiB, WS_WOUT = 22 * MiB, WS_WGU2 = 24 * MiB, WS_WD2 = 35 * MiB;
constexpr size_t WS_TRIL = 41 * MiB, WS_ROPE = 42 * MiB, WS_SS1 = 44 * MiB, WS_SS2 = 46 * MiB, WS_SS3 = 48 * MiB, WS_SSV = 50 * MiB;
constexpr size_t WS_XB = 52 * MiB;
constexpr size_t WS_H = 86 * MiB;
constexpr size_t WS_Z = WS_H, WS_AO = WS_H + (size_t)M * DIN * 2;
constexpr size_t WS_END = WS_H + (size_t)M * FF * 2;
static_assert(WS_AO + (size_t)M * DM * 2 <= WS_END && WS_END <= 256 * MiB && WS_XB + (size_t)M * DM * 2 <= WS_H, "d_ws map");
static_assert(WS_WGU1 + (size_t)NGU * DM * 2 <= WS_WD1 && WS_WD1 + (size_t)DM * FF * 2 <= WS_WIN && WS_WIN + (size_t)DIN * DM * 2 <= WS_WOUT && WS_WGU2 + (size_t)NGU * DM * 2 <= WS_WD2 && WS_WD2 + (size_t)DM * FF * 2 <= WS_TRIL, "weights map");
static_assert(WS_ROPE + 4100 * 64 * 4 <= WS_SS1 && WS_SS1 + (size_t)M * 64 <= WS_SS2 && WS_SSV + (size_t)M * 32 <= WS_XB, "small tables map");
constexpr int CW_TMO = 0, CW_CODE = 1, CW_BAR = 4096;
constexpr int RING_OFF = 0, PHASE_BYTES = 139264;
constexpr int XCH_OFF = 135168;
constexpr int LDSCTL_OFF = PHASE_BYTES, MISC_OFF = LDSCTL_OFF + 320;
constexpr int LDS_BYTES = 147456;
static_assert(MISC_OFF + 128 <= LDS_BYTES && XCH_OFF + 4096 <= PHASE_BYTES, "LDS map");

#define GAS __attribute__((address_space(1)))
#define LAS __attribute__((address_space(3)))
typedef unsigned short bf16;
typedef unsigned v4u __attribute__((ext_vector_type(4)));
typedef unsigned v2u __attribute__((ext_vector_type(2)));
typedef float f32x4 __attribute__((ext_vector_type(4)));
typedef short bf16x8 __attribute__((ext_vector_type(8)));
typedef short s16x4 __attribute__((ext_vector_type(4)));
typedef GAS unsigned gu32;
typedef GAS unsigned long long gu64;
#define RLX_AGENT __ATOMIC_RELAXED, __HIP_MEMORY_SCOPE_AGENT
#define LDS_WAIT() asm volatile("s_waitcnt lgkmcnt(0)" ::: "memory")
#define VM_WAIT() asm volatile("s_waitcnt vmcnt(0)" ::: "memory")
__device__ __forceinline__ unsigned f2bf(float f) { unsigned u = __builtin_bit_cast(unsigned, f); return (u + 0x7fffu + ((u >> 16) & 1u)) >> 16; }
__device__ __forceinline__ unsigned pk2(float lo, float hi) { return f2bf(lo) | (f2bf(hi) << 16); }
__device__ __forceinline__ float bf_lo(unsigned w) { return __builtin_bit_cast(float, w << 16); }
__device__ __forceinline__ float bf_hi(unsigned w) { return __builtin_bit_cast(float, w & 0xffff0000u); }
__device__ __forceinline__ float xs4(float s) { s += __shfl_xor(s, 16); s += __shfl_xor(s, 32); return s; }
__device__ __forceinline__ float wave_sum(float v) {
#pragma unroll
    for (int o = 1; o < 64; o <<= 1) v += __shfl_xor(v, o);
    return v;
}
#define XB_TMO      128
#define XB_XCNT(j)  (256  + 64 * (j))
#define XB_XSUB(j)  (1280 + 64 * (j))
#define XB_XGEN(j)  (2304 + 64 * (j))
#define XB_TOP      3328
#define XB_TOPGEN   3392
#define XCD_BAR_WORDS 3456
#define XB_SPIN_CAP (1u << 18)

__device__ __forceinline__ unsigned xb_ld(unsigned* p)              { return __hip_atomic_load(p, __ATOMIC_RELAXED, __HIP_MEMORY_SCOPE_AGENT); }
__device__ __forceinline__ unsigned xb_add(unsigned* p, unsigned v) { return __hip_atomic_fetch_add(p, v, __ATOMIC_RELAXED, __HIP_MEMORY_SCOPE_AGENT); }
__device__ __forceinline__ unsigned xb_xcc_id() { return (unsigned)__builtin_amdgcn_s_getreg((3 << 11) | 20) & 0xFu; }
#define XB_SPIN(cond, bar) do { unsigned _sp = 0; while (cond) { __builtin_amdgcn_s_sleep(1); \
    if ((++_sp & 255u) == 0u) { if (xb_ld(&(bar)[XB_TMO])) break; if (_sp > XB_SPIN_CAP) { atomicAdd(&(bar)[XB_TMO], 1u); break; } } } } while (0)

struct XcdBarrier {
    unsigned* bar; unsigned x;
    volatile LAS unsigned* st;
};

__device__ __forceinline__ XcdBarrier xcd_barrier_post(unsigned* bar, volatile LAS unsigned* st) {
    XcdBarrier b; b.bar = bar; b.x = xb_xcc_id(); b.st = st;
    if (threadIdx.x == 0) (void)xb_add(&bar[XB_XCNT(b.x)], 1u);
    return b;
}
__device__ __forceinline__ void xcd_barrier_complete(unsigned* bar, unsigned x, unsigned& nloc, unsigned& nx) {
    const unsigned G = gridDim.x * gridDim.y * gridDim.z;
    unsigned sum, cnt, mine, sp = 0u;
    for (;;) {
        sum = 0u; cnt = 0u; mine = 0u;
#pragma unroll
        for (unsigned j = 0; j < 16; ++j) { const unsigned c = xb_ld(&bar[XB_XCNT(j)]); sum += c; cnt += (c > 0u) ? 1u : 0u; mine = (j == x) ? c : mine; }
        if (sum == G) break;
        __builtin_amdgcn_s_sleep(1);
        if ((++sp & 255u) == 0u) { if (xb_ld(&bar[XB_TMO])) break; if (sp > XB_SPIN_CAP) { atomicAdd(&bar[XB_TMO], 1u); break; } }
    }
    nloc = mine > 0u ? mine : 1u; nx = cnt > 0u ? cnt : 1u;
}

__device__ __forceinline__ void xcd_barrier(const XcdBarrier& b) {
    asm volatile("s_waitcnt vmcnt(0)" ::: "memory");
    __syncthreads();
    if (threadIdx.x == 0) {
        unsigned* bar = b.bar;
        __builtin_amdgcn_s_waitcnt(0);
        unsigned nloc = b.st[0], nx = b.st[1];
        if (nloc == 0u) { xcd_barrier_complete(bar, b.x, nloc, nx); b.st[0] = nloc; b.st[1] = nx; }
        const unsigned old = xb_add(&bar[XB_XSUB(b.x)], 1u);
        const unsigned gen = old / nloc;
        if (old + 1u == (gen + 1u) * nloc) {
            __builtin_amdgcn_fence(__ATOMIC_RELEASE, "agent");
            asm volatile("s_waitcnt vmcnt(0)" ::: "memory");
            const unsigned og = xb_add(&bar[XB_TOP], 1u);
            const unsigned tg = og / nx;
            if (og + 1u == (tg + 1u) * nx) xb_add(&bar[XB_TOPGEN], 1u);
            else XB_SPIN(xb_ld(&bar[XB_TOPGEN]) == tg, bar);
            __builtin_amdgcn_fence(__ATOMIC_ACQUIRE, "agent");
            xb_add(&bar[XB_XGEN(b.x)], 1u);
            asm volatile("s_waitcnt vmcnt(0)" ::: "memory");
        } else {
            XB_SPIN(xb_ld(&bar[XB_XGEN(b.x)]) == gen, bar);
            __builtin_amdgcn_fence(__ATOMIC_ACQUIRE, "agent");
            asm volatile("s_waitcnt vmcnt(0)" ::: "memory");
        }
    }
    __syncthreads();
}


struct Frame {
    LAS unsigned char* lds;
    volatile LAS unsigned* MISC;
    gu32* ctl;
    int tid, lane, wave;
    int vcu, G;
    const float* in[22]; float* out; unsigned char* ws;
};
__constant__ float c_inv_freq[32] = {
    1.000000000e+00f, 7.498942018e-01f, 5.623413324e-01f, 4.216965139e-01f, 3.162277639e-01f, 2.371373773e-01f, 1.778279394e-01f, 1.333521456e-01f,
    1.000000015e-01f, 7.498942316e-02f, 5.623413250e-02f, 4.216964915e-02f, 3.162277490e-02f, 2.371373773e-02f, 1.778279431e-02f, 1.333521400e-02f,
    9.999999776e-03f, 7.498942316e-03f, 5.623413250e-03f, 4.216964822e-03f, 3.162277630e-03f, 2.371373819e-03f, 1.778279431e-03f, 1.333521446e-03f,
    1.000000047e-03f, 7.498941850e-04f, 5.623413017e-04f, 4.216965172e-04f, 3.162277571e-04f, 2.371373703e-04f, 1.778279402e-04f, 1.333521504e-04f };

__device__ __forceinline__ void p0_transpose_item(const float* W, int K, int N, bf16* WT, int mode, const float* gk, LAS float* scr, int item, int lane) {
    const int nblk = N / 32, kb = item / nblk, nb = item % nblk, k0 = 64 * kb, n0 = 32 * nb;
    int rb = n0;
    if (mode == 1) rb = 256 * (n0 >> 7) + (n0 & 127);
    else if (mode == 2) rb = 256 * (n0 >> 7) + 128 + (n0 & 127);
    else if (mode == 3) rb = (n0 & ~0xE0) | (((n0 >> 5) & 1) << 7) | (((n0 >> 6) & 3) << 5);
#pragma unroll 8
    for (int i = 0; i < 32; ++i) { const int kk = 2 * i + (lane >> 5); scr[kk * 33 + (lane & 31)] = W[(size_t)(k0 + kk) * N + n0 + (lane & 31)]; }
    LDS_WAIT(); asm volatile("" ::: "memory");
    const int c = lane & 7;
    float g8[8];
#pragma unroll
    for (int e = 0; e < 8; ++e) g8[e] = gk ? gk[k0 + 8 * c + e] : 1.0f;
#pragma unroll
    for (int j = 0; j < 4; ++j) { const int n = (lane >> 3) + 8 * j; const LAS float* s = scr + (8 * c) * 33 + n;
        v4u o; o.x = pk2(s[0 * 33] * g8[0], s[1 * 33] * g8[1]); o.y = pk2(s[2 * 33] * g8[2], s[3 * 33] * g8[3]); o.z = pk2(s[4 * 33] * g8[4], s[5 * 33] * g8[5]); o.w = pk2(s[6 * 33] * g8[6], s[7 * 33] * g8[7]);
        *(GAS v4u*)(WT + (size_t)(rb + n) * K + k0 + 8 * c) = o; }
    LDS_WAIT(); asm volatile("" ::: "memory");
}
__device__ __forceinline__ void rms_row_to_bf16(int lane, const float* xrow, const float* gain, bf16* orow) {
    const GAS f32x4* xr = (const GAS f32x4*)xrow + lane; const GAS f32x4* gr = (const GAS f32x4*)gain + lane;
    f32x4 v[4]; float s = 0.f;
#pragma unroll
    for (int j = 0; j < 4; ++j) { v[j] = xr[64 * j]; s += (v[j].x * v[j].x + v[j].y * v[j].y) + (v[j].z * v[j].z + v[j].w * v[j].w); }
    const float rs = 1.0f / sqrtf(wave_sum(s) * (1.f / DM) + EPS);
    GAS unsigned long long* o8 = (GAS unsigned long long*)orow + lane;
#pragma unroll
    for (int j = 0; j < 4; ++j) { const f32x4 g = gr[64 * j]; o8[64 * j] = (unsigned long long)pk2(v[j].x * rs * g.x, v[j].y * rs * g.y) | ((unsigned long long)pk2(v[j].z * rs * g.z, v[j].w * rs * g.w) << 32); }
}
__device__ __forceinline__ void sincos_d(float ang, float& sn, float& cs) {
    const double x = (double)ang; const double kd = __builtin_rint(x * 0.63661977236758134308);
    const double r = __builtin_fma(-kd, 6.123233995736766036e-17, __builtin_fma(-kd, 1.5707963267948966192, x)); const double r2 = r * r;
    double ps = -7.6471637318198164759e-13; ps = ps * r2 + 1.6059043836821614599e-10; ps = ps * r2 - 2.5052108385441718775e-08; ps = ps * r2 + 2.7557319223985890653e-06; ps = ps * r2 - 1.9841269841269841270e-04;
    ps = ps * r2 + 8.3333333333333333333e-03; ps = ps * r2 - 1.6666666666666666667e-01; const double s = r + r * r2 * ps;
    double pc = 4.7794773323873852974e-14; pc = pc * r2 - 1.1470745597729724714e-11; pc = pc * r2 + 2.0876756987868098979e-09; pc = pc * r2 - 2.7557319223985890653e-07; pc = pc * r2 + 2.4801587301587301587e-05;
    pc = pc * r2 - 1.3888888888888888889e-03; pc = pc * r2 + 4.1666666666666666667e-02; pc = pc * r2 - 0.5; const double c = 1.0 + r2 * pc;
    const int q = (int)kd & 3;
    const double ss = (q & 1) ? c : s, cc = (q & 1) ? s : c;
    sn = (float)((q & 2) ? -ss : ss); cs = (float)(((q + 1) & 2) ? -cc : cc);
}
__device__ __forceinline__ void p0_prologue(Frame& F) {
    LAS float* scr = (LAS float*)(F.lds + RING_OFF + F.wave * 16384);
    const int gw = F.vcu * NWAVES + F.wave, NGW = F.G * NWAVES;
    bf16* Wgu1 = (bf16*)(F.ws + WS_WGU1); bf16* Wd1 = (bf16*)(F.ws + WS_WD1); bf16* Win = (bf16*)(F.ws + WS_WIN); bf16* Wout = (bf16*)(F.ws + WS_WOUT); bf16* Wgu2 = (bf16*)(F.ws + WS_WGU2); bf16* Wd2 = (bf16*)(F.ws + WS_WD2);
    constexpr int I_GU = (DM / 64) * (FF / 32), I_D = (FF / 64) * (DM / 32), I_IN = (DM / 64) * (DIN / 32), I_OUT = (DM / 64) * (DM / 32);
    constexpr int NITEMS = 4 * I_GU + 2 * I_D + I_IN + I_OUT;
    for (int it = gw; it < NITEMS; it += NGW) {
        int r = it;
        if (r < I_GU) { p0_transpose_item(F.in[5], DM, FF, Wgu1, 1, nullptr, scr, r, F.lane); continue; } r -= I_GU;
        if (r < I_GU) { p0_transpose_item(F.in[6], DM, FF, Wgu1, 2, nullptr, scr, r, F.lane); continue; } r -= I_GU;
        if (r < I_D) { p0_transpose_item(F.in[7], FF, DM, Wd1, 0, nullptr, scr, r, F.lane); continue; } r -= I_D;
        if (r < I_IN) { p0_transpose_item(F.in[9], DM, DIN, Win, 3, F.in[8], scr, r, F.lane); continue; } r -= I_IN;
        if (r < I_OUT) { p0_transpose_item(F.in[16], DM, DM, Wout, 0, nullptr, scr, r, F.lane); continue; } r -= I_OUT;
        if (r < I_GU) { p0_transpose_item(F.in[18], DM, FF, Wgu2, 1, F.in[17], scr, r, F.lane); continue; } r -= I_GU;
        if (r < I_GU) { p0_transpose_item(F.in[19], DM, FF, Wgu2, 2, F.in[17], scr, r, F.lane); continue; } r -= I_GU;
        p0_transpose_item(F.in[20], FF, DM, Wd2, 0, nullptr, scr, r, F.lane);
    }
    bf16* XB = (bf16*)(F.ws + WS_XB);
    for (int m = gw; m < M; m += NGW) { const float* xr = (m < MP) ? F.in[0] + (size_t)m * DM : F.in[1] + (size_t)(m - MP) * DM; rms_row_to_bf16(F.lane, xr, F.in[4], XB + (size_t)m * DM); }
    float* rope = (float*)(F.ws + WS_ROPE);
    const int gt = F.vcu * (NWAVES * 64) + F.tid, NGT = F.G * NWAVES * 64;
    for (int e = gt; e < 4100 * 32; e += NGT) { const int pi = e >> 5, i = e & 31; const int pos = pi < 4096 ? pi : 16384 + (pi - 4096);
        const float ang = (float)pos * c_inv_freq[i]; float sn, cs; sincos_d(ang, sn, cs); rope[pi * 64 + i] = cs; rope[pi * 64 + 32 + i] = sn; }
    bf16* tril = (bf16*)(F.ws + WS_TRIL);
    for (int e = gt; e < 8 * 128 * 128; e += NGT) { const int s = e & 127, t = (e >> 7) & 127; tril[e] = (bf16)f2bf(s <= t ? F.in[12][e] : 0.f); }
}

constexpr int KVS = 160;
constexpr int GVS = 1056;
typedef short v4i16_t __attribute__((ext_vector_type(4)));
__device__ __forceinline__ s16x4 vtr(LAS const unsigned char* p) { return __builtin_bit_cast(s16x4, __builtin_amdgcn_ds_read_tr16_b64_v4i16((LAS v4i16_t*)p)); }
__device__ __forceinline__ unsigned cvtpk(float lo, float hi) { unsigned r; asm volatile("v_cvt_pk_bf16_f32 %0, %1, %2" : "=v"(r) : "v"(lo), "v"(hi)); return r; }
#define MFMA16(a, b, c) __builtin_amdgcn_mfma_f32_16x16x32_bf16((a), (b), (c), 0, 0, 0)
template <int K, class Epi> __device__ __forceinline__ void mini_gemm(LAS unsigned char* lds, const bf16* A, const bf16* Bt, int rowbase, int tile, const Epi& E, int tid, int wave, int lane) {
    constexpr int KW = K / 8, NKS = KW / 32, CH = 4, NCH = (NKS + CH - 1) / CH; static_assert(KW % 32 == 0 && NCH <= 3, "K / 8 must be a multiple of 32");
    const int rt = tile >> 4, ct = tile & 15, g = lane >> 4, fr = lane & 15;
    const bf16* ap = A + (size_t)(rt * 32 + fr) * K + wave * KW + 8 * g;
    const bf16* bp = Bt + (size_t)(ct * 64 + fr) * K + wave * KW + 8 * g;
    f32x4 acc[2][4];
#pragma unroll
    for (int i = 0; i < 2; ++i)
#pragma unroll
        for (int c = 0; c < 4; ++c) acc[i][c] = (f32x4){0.f, 0.f, 0.f, 0.f};
    bf16x8 fa[3][CH][2], fb[3][CH][4];
#define MINI_LOAD(ch) do { _Pragma("unroll") for (int k = 0; k < CH; ++k) if ((ch) * CH + k < NKS) { \
        _Pragma("unroll") for (int i = 0; i < 2; ++i) fa[ch][k][i] = *(const GAS bf16x8*)(ap + (size_t)i * 16 * K + ((ch) * CH + k) * 32); \
        _Pragma("unroll") for (int c = 0; c < 4; ++c) fb[ch][k][c] = *(const GAS bf16x8*)(bp + (size_t)c * 16 * K + ((ch) * CH + k) * 32); } } while (0)
#define MINI_MMA(ch) do { _Pragma("unroll") for (int k = 0; k < CH; ++k) if ((ch) * CH + k < NKS) { \
        _Pragma("unroll") for (int i = 0; i < 2; ++i) _Pragma("unroll") for (int c = 0; c < 4; ++c) acc[i][c] = MFMA16(fb[ch][k][c], fa[ch][k][i], acc[i][c]); } } while (0)
    MINI_LOAD(0); if (NCH > 1) MINI_LOAD(1);
    __builtin_amdgcn_sched_barrier(0);
    MINI_MMA(0);
    if (NCH > 2) { __builtin_amdgcn_sched_barrier(0); MINI_LOAD(2); __builtin_amdgcn_sched_barrier(0); }
    if (NCH > 1) MINI_MMA(1);
    if (NCH > 2) MINI_MMA(2);
#undef MINI_LOAD
#undef MINI_MMA
    LAS f32x4* P = (LAS f32x4*)lds;
#pragma unroll
    for (int i = 0; i < 2; ++i)
#pragma unroll
        for (int c = 0; c < 4; ++c) P[((wave * 2 + i) * 4 + c) * 64 + lane] = acc[i][c];
    __syncthreads();
    const int r = tid >> 4, cg = tid & 15; const int src = (((r >> 4) * 4 + (cg >> 2)) * 64) + (r & 15) + 16 * (cg & 3);
    f32x4 sum = P[src];
#pragma unroll
    for (int w = 1; w < 8; ++w) sum = sum + P[w * 512 + src];
    float q = E.apply4(rowbase + rt * 32 + r, ct * 64 + 4 * cg, sum);
    q += __shfl_xor(q, 1); q += __shfl_xor(q, 2); q += __shfl_xor(q, 4); q += __shfl_xor(q, 8);
    if (cg == 0) E.ss[(size_t)(rowbase + rt * 32 + r) * 16 + ct] = q;
    __syncthreads();
}

template <int NF> __device__ __forceinline__ void attn_core(f32x4 (&o)[4], bf16x8 qf0, bf16x8 qf1, LAS const unsigned char* kp, LAS const unsigned char* vp, int slot0, int slot_lo, int slot_hi, float sink2) {
    f32x4 s[NF];
#pragma unroll
    for (int f = 0; f < NF; ++f) { const bf16x8 k0 = *(const LAS bf16x8*)(kp + f * 16 * KVS), k1 = *(const LAS bf16x8*)(kp + f * 16 * KVS + 64);
        s[f] = MFMA16(k0, qf0, ((f32x4){0.f, 0.f, 0.f, 0.f})); s[f] = MFMA16(k1, qf1, s[f]); }
    float mx = sink2;
#pragma unroll
    for (int f = 0; f < NF; ++f)
#pragma unroll
        for (int r = 0; r < 4; ++r) { const int slot = slot0 + 16 * f + r; const float v = (slot >= slot_lo && slot <= slot_hi) ? s[f][r] : -INFINITY; s[f][r] = v; mx = fmaxf(mx, v); }
    mx = fmaxf(mx, __shfl_xor(mx, 16)); mx = fmaxf(mx, __shfl_xor(mx, 32));
    float l = 0.f;
#pragma unroll
    for (int f = 0; f < NF; ++f)
#pragma unroll
        for (int r = 0; r < 4; ++r) { const float p = __builtin_amdgcn_exp2f(s[f][r] - mx); s[f][r] = p; l += p; }
    l = xs4(l) + __builtin_amdgcn_exp2f(sink2 - mx);
#pragma unroll
    for (int d0 = 0; d0 < 4; ++d0) o[d0] = (f32x4){0.f, 0.f, 0.f, 0.f};
#pragma unroll
    for (int kk = 0; kk < (NF + 1) / 2; ++kk) { const int f0 = 2 * kk, f1 = (2 * kk + 1 < NF) ? 2 * kk + 1 : f0; const bool two = (2 * kk + 1 < NF);
        v4u pw; pw.x = cvtpk(s[f0][0], s[f0][1]); pw.y = cvtpk(s[f0][2], s[f0][3]); pw.z = two ? cvtpk(s[f1][0], s[f1][1]) : 0u; pw.w = two ? cvtpk(s[f1][2], s[f1][3]) : 0u;
        const bf16x8 pb = __builtin_bit_cast(bf16x8, pw);
#pragma unroll
        for (int d0 = 0; d0 < 4; ++d0) { const s16x4 lo = vtr(vp + f0 * 16 * KVS + d0 * 32), hi = vtr(vp + f1 * 16 * KVS + d0 * 32);
            const bf16x8 va = (bf16x8){lo[0], lo[1], lo[2], lo[3], hi[0], hi[1], hi[2], hi[3]};
            o[d0] = MFMA16(va, pb, o[d0]); } }
    const float inv = 1.0f / l;
#pragma unroll
    for (int d0 = 0; d0 < 4; ++d0) o[d0] = o[d0] * inv;
}

__device__ __forceinline__ void p4_attn_unit(Frame& F, int b, int j) {
    const bf16* Z = (const bf16*)(F.ws + WS_Z); bf16* AO = (bf16*)(F.ws + WS_AO);
    LAS unsigned char* Kl = F.lds; LAS unsigned char* Vl = F.lds + 2 * 192 * KVS; LAS float* xch = (LAS float*)(F.lds + XCH_OFF);
    const int lane = F.lane, w = F.wave, g = lane >> 4, ql = lane & 15;
    const int kb0 = 64 * j - 128;
    for (int i = F.tid; i < 192 * 32; i += NWAVES * 64) { const int slot = i >> 5, within = i & 31, pos = kb0 + slot;
        v4u v = (v4u){0u, 0u, 0u, 0u};
        if (pos >= 0) v = *(const GAS v4u*)(Z + (size_t)(b * 4096 + pos) * DIN + ZK + within * 8);
        LAS unsigned char* dst = ((within & 16) ? Vl : Kl) + ((within >> 3) & 1) * (192 * KVS) + slot * KVS + (within & 7) * 16;
        *(LAS v4u*)dst = v; }
    __syncthreads();
    const int kvh = w >> 2; const float sink2 = F.in[10][w] * LOG2E_F;
    LAS const unsigned char* Kb = Kl + kvh * (192 * KVS); LAS const unsigned char* Vb = Vl + kvh * (192 * KVS);
    const int smin = (kb0 < 0) ? -kb0 : 0;
    f32x4 o[4][4];
#pragma unroll
    for (int qf = 0; qf < 4; ++qf) {
        const size_t m = (size_t)b * 4096 + 64 * j + 16 * qf + ql;
        const bf16x8 qf0 = *(const GAS bf16x8*)(Z + m * DIN + ZQ + w * 64 + 8 * g), qf1 = *(const GAS bf16x8*)(Z + m * DIN + ZQ + w * 64 + 32 + 8 * g);
        const int lo = 16 * qf + ql + 1;
        attn_core<9>(o[qf], qf0, qf1, Kb + (16 * qf + ql) * KVS + 16 * g, Vb + (16 * qf + 4 * g + (ql >> 2)) * KVS + 8 * (ql & 3), 16 * qf + 4 * g, lo > smin ? lo : smin, 16 * qf + ql + 128, sink2);
        float q = 0.f;
#pragma unroll
        for (int d0 = 0; d0 < 4; ++d0) q += (o[qf][d0][0] * o[qf][d0][0] + o[qf][d0][1] * o[qf][d0][1]) + (o[qf][d0][2] * o[qf][d0][2] + o[qf][d0][3] * o[qf][d0][3]);
        q = xs4(q);
        if (g == 0) xch[(16 * qf + ql) * 8 + w] = q;
    }
    __syncthreads();
    const float* ga = F.in[14];
#pragma unroll
    for (int qf = 0; qf < 4; ++qf) {
        const f32x4 t0 = *(const LAS f32x4*)(xch + (16 * qf + ql) * 8), t1 = *(const LAS f32x4*)(xch + (16 * qf + ql) * 8 + 4);
        const float tot = ((t0[0] + t0[1]) + (t0[2] + t0[3])) + ((t1[0] + t1[1]) + (t1[2] + t1[3]));
        const float ra = 1.0f / sqrtf(tot * (1.0f / 512.0f) + EPS);
        const size_t m = (size_t)b * 4096 + 64 * j + 16 * qf + ql;
#pragma unroll
        for (int d0 = 0; d0 < 4; ++d0) { const int col = w * 64 + 16 * d0 + 4 * g; const f32x4 gn = *(const GAS f32x4*)(ga + col); const f32x4 v = o[qf][d0] * ra * gn;
            v2u pk; pk.x = cvtpk(v[0], v[1]); pk.y = cvtpk(v[2], v[3]); *(GAS v2u*)(AO + m * DM + col) = pk; }
    }
    __syncthreads();
}

__device__ __forceinline__ void p4_gmlp_unit(Frame& F, int b, int hc) {
    const bf16* Z = (const bf16*)(F.ws + WS_Z); bf16* AO = (bf16*)(F.ws + WS_AO); const float* ssv = (const float*)(F.ws + WS_SSV); const bf16* tril = (const bf16*)(F.ws + WS_TRIL);
    LAS unsigned char* Gl = F.lds; LAS float* xch = (LAS float*)(F.lds + XCH_OFF);
    const int lane = F.lane, w = F.wave, g = lane >> 4, ql = lane & 15;
    const int n = hc >> 1, half = hc & 1, ns = 64 * (half + 1); const size_t m0 = (size_t)b * 4096 + 128 * n;
    {
        const int cc = F.tid & 63; const f32x4 gv0 = *(const GAS f32x4*)(F.in[11] + 8 * cc), gv1 = *(const GAS f32x4*)(F.in[11] + 8 * cc + 4);
        const bool wout = (n == 31 && half == 1); float* ogp = F.out + O_GP;
        for (int sr = w; sr < ns; sr += NWAVES) { const size_t m = m0 + sr;
            const f32x4 p0 = *(const GAS f32x4*)(ssv + m * 8), p1 = *(const GAS f32x4*)(ssv + m * 8 + 4);
            const float rs = 1.0f / sqrtf((((p0[0] + p0[1]) + (p0[2] + p0[3])) + ((p1[0] + p1[1]) + (p1[2] + p1[3]))) * (1.0f / 512.0f) + EPS);
            const v4u raw = *(const GAS v4u*)(Z + m * DIN + ZG + 8 * cc);
            const f32x4 a = (f32x4){bf_lo(raw.x), bf_hi(raw.x), bf_lo(raw.y), bf_hi(raw.y)} * rs * gv0, c = (f32x4){bf_lo(raw.z), bf_hi(raw.z), bf_lo(raw.w), bf_hi(raw.w)} * rs * gv1;
            v4u pk; pk.x = cvtpk(a[0], a[1]); pk.y = cvtpk(a[2], a[3]); pk.z = cvtpk(c[0], c[1]); pk.w = cvtpk(c[2], c[3]);
            *(LAS v4u*)(Gl + sr * GVS + cc * 16) = pk;
            if (wout) { float* op = ogp + ((size_t)b * 128 + sr) * 512 + 8 * cc; *(GAS f32x4*)op = a; *(GAS f32x4*)(op + 4) = c; } }
    }
    __syncthreads();
    f32x4 y[4][4];
#pragma unroll
    for (int tf = 0; tf < 4; ++tf) {
        const int tc = 64 * half + 16 * tf + ql; const size_t mt = m0 + tc;
        const int nfr = 4 * half + tf + 1, npair = (nfr + 1) >> 1;
        f32x4 acc[4];
#pragma unroll
        for (int d0 = 0; d0 < 4; ++d0) acc[d0] = (f32x4){0.f, 0.f, 0.f, 0.f};
        const bf16* wrow = tril + ((size_t)w * 128 + tc) * 128 + 4 * g;
        LAS const unsigned char* gp = Gl + (4 * g + (ql >> 2)) * GVS + (w * 64 + 4 * (ql & 3)) * 2;
        for (int kk = 0; kk < npair; ++kk) { const int f0 = 2 * kk; const bool two = (2 * kk + 1 < nfr); const int f1 = two ? f0 + 1 : f0;
            v2u w0 = *(const GAS v2u*)(wrow + 16 * f0), w1 = *(const GAS v2u*)(wrow + 16 * f1); if (!two) w1 = (v2u){0u, 0u};
            const bf16x8 pb = __builtin_bit_cast(bf16x8, ((v4u){w0.x, w0.y, w1.x, w1.y}));
#pragma unroll
            for (int d0 = 0; d0 < 4; ++d0) { const s16x4 lo = vtr(gp + f0 * 16 * GVS + d0 * 32), hi = vtr(gp + f1 * 16 * GVS + d0 * 32);
                const bf16x8 va = (bf16x8){lo[0], lo[1], lo[2], lo[3], hi[0], hi[1], hi[2], hi[3]};
                acc[d0] = MFMA16(va, pb, acc[d0]); } }
        const float bias = F.in[13][w * 128 + tc]; float q = 0.f;
#pragma unroll
        for (int d0 = 0; d0 < 4; ++d0) { const v2u ur = *(const GAS v2u*)(Z + mt * DIN + ZU + w * 64 + 16 * d0 + 4 * g);
            const f32x4 uu = (f32x4){bf_lo(ur.x), bf_hi(ur.x), bf_lo(ur.y), bf_hi(ur.y)}; const f32x4 v = uu * (acc[d0] + bias); y[tf][d0] = v;
            q += (v[0] * v[0] + v[1] * v[1]) + (v[2] * v[2] + v[3] * v[3]); }
        q = xs4(q);
        if (g == 0) xch[(16 * tf + ql) * 8 + w] = q;
    }
    __syncthreads();
    const float* gg = F.in[15];
#pragma unroll
    for (int tf = 0; tf < 4; ++tf) {
        const f32x4 t0 = *(const LAS f32x4*)(xch + (16 * tf + ql) * 8), t1 = *(const LAS f32x4*)(xch + (16 * tf + ql) * 8 + 4);
        const float tot = ((t0[0] + t0[1]) + (t0[2] + t0[3])) + ((t1[0] + t1[1]) + (t1[2] + t1[3]));
        const float rg = 1.0f / sqrtf(tot * (1.0f / 512.0f) + EPS);
        const size_t mt = m0 + 64 * half + 16 * tf + ql;
#pragma unroll
        for (int d0 = 0; d0 < 4; ++d0) { const int col = w * 64 + 16 * d0 + 4 * g; const f32x4 gn = *(const GAS f32x4*)(gg + col); const f32x4 v = y[tf][d0] * rg * gn;
            v2u pk; pk.x = cvtpk(v[0], v[1]); pk.y = cvtpk(v[2], v[3]); *(GAS v2u*)(AO + mt * DM + 512 + col) = pk; }
    }
    __syncthreads();
}

__device__ __forceinline__ void p4_sample_unit(Frame& F, int b) {
    const bf16* Z = (const bf16*)(F.ws + WS_Z); bf16* AO = (bf16*)(F.ws + WS_AO); const float* ssv = (const float*)(F.ws + WS_SSV);
    LAS unsigned char* Kl = F.lds; LAS unsigned char* Vl = F.lds + 2 * 144 * KVS; LAS float* xch = (LAS float*)(F.lds + XCH_OFF); LAS float* xch2 = xch + 512;
    const int lane = F.lane, w = F.wave, g = lane >> 4, ql = lane & 15, tid = F.tid;
    const float* ck = F.in[2] + (size_t)b * 128 * 128; const float* cv = F.in[3] + (size_t)b * 128 * 128;
    float* oks = F.out + O_KS + (size_t)b * 128 * 128; float* ovs = F.out + O_VS + (size_t)b * 128 * 128;
    for (int i = tid; i < 128 * 32; i += NWAVES * 64) { const int jr = i >> 5, c = i & 31, kvh = c >> 4, d4 = (c & 15) * 4;
        const f32x4 vk = *(const GAS f32x4*)(ck + jr * 128 + c * 4), vv = *(const GAS f32x4*)(cv + jr * 128 + c * 4);
        v2u pk; pk.x = cvtpk(vk[0], vk[1]); pk.y = cvtpk(vk[2], vk[3]); *(LAS v2u*)(Kl + kvh * (144 * KVS) + jr * KVS + d4 * 2) = pk;
        v2u pv; pv.x = cvtpk(vv[0], vv[1]); pv.y = cvtpk(vv[2], vv[3]); *(LAS v2u*)(Vl + kvh * (144 * KVS) + jr * KVS + d4 * 2) = pv;
        if (jr >= 4) { *(GAS f32x4*)(oks + (jr - 4) * 128 + c * 4) = vk; *(GAS f32x4*)(ovs + (jr - 4) * 128 + c * 4) = vv; } }
    if (tid < 128) { const int t = tid >> 5, within = tid & 31;
        const v4u v = *(const GAS v4u*)(Z + (size_t)(MP + 4 * b + t) * DIN + ZK + within * 8);
        LAS unsigned char* dst = ((within & 16) ? Vl : Kl) + ((within >> 3) & 1) * (144 * KVS) + (128 + t) * KVS + (within & 7) * 16; *(LAS v4u*)dst = v; }
    else if (tid < 128 + 384) { const int e = tid - 128, r = e >> 5, within = e & 31;
        LAS unsigned char* dst = ((within & 16) ? Vl : Kl) + ((within >> 3) & 1) * (144 * KVS) + (132 + r) * KVS + (within & 7) * 16; *(LAS v4u*)dst = (v4u){0u, 0u, 0u, 0u}; }
    __syncthreads();
    f32x4 o[4]; const int t_q = ql & 3, hq = ql >> 2;
    if (w < 2) {
        const int h = 4 * w + hq; const size_t m = (size_t)MP + 4 * b + t_q; const float sink2 = F.in[10][h] * LOG2E_F;
        const bf16x8 qf0 = *(const GAS bf16x8*)(Z + m * DIN + ZQ + h * 64 + 8 * g), qf1 = *(const GAS bf16x8*)(Z + m * DIN + ZQ + h * 64 + 32 + 8 * g);
        attn_core<9>(o, qf0, qf1, Kl + w * (144 * KVS) + ql * KVS + 16 * g, Vl + w * (144 * KVS) + (4 * g + (ql >> 2)) * KVS + 8 * (ql & 3), 4 * g, t_q + 1, t_q + 128, sink2);
        float q = 0.f;
#pragma unroll
        for (int d0 = 0; d0 < 4; ++d0) q += (o[d0][0] * o[d0][0] + o[d0][1] * o[d0][1]) + (o[d0][2] * o[d0][2] + o[d0][3] * o[d0][3]);
        q = xs4(q); q += __shfl_xor(q, 4); q += __shfl_xor(q, 8);
        if (lane < 4) xch[lane * 8 + w] = q;
    }
    const int c = tid; float gvn[4], yg[4];
    {
        const float gvc = F.in[11][c]; float* ogs = F.out + O_GS + (size_t)b * 4 * 512;
#pragma unroll
        for (int s = 0; s < 4; ++s) { const size_t m = (size_t)MP + 4 * b + s;
            const f32x4 p0 = *(const GAS f32x4*)(ssv + m * 8), p1 = *(const GAS f32x4*)(ssv + m * 8 + 4);
            const float rs = 1.0f / sqrtf((((p0[0] + p0[1]) + (p0[2] + p0[3])) + ((p1[0] + p1[1]) + (p1[2] + p1[3]))) * (1.0f / 512.0f) + EPS);
            const float raw = __builtin_bit_cast(float, (unsigned)Z[m * DIN + ZG + c] << 16); gvn[s] = raw * rs * gvc; ogs[s * 512 + c] = gvn[s]; }
#pragma unroll
        for (int t = 0; t < 4; ++t) { const size_t m = (size_t)MP + 4 * b + t; float mix = F.in[13][w * 128 + t];
#pragma unroll
            for (int s = 0; s <= t; ++s) mix += F.in[12][((size_t)w * 128 + t) * 128 + s] * gvn[s];
            const float uu = __builtin_bit_cast(float, (unsigned)Z[m * DIN + ZU + c] << 16); yg[t] = uu * mix;
            const float q = wave_sum(yg[t] * yg[t]); if (lane == 0) xch2[t * 8 + w] = q; }
    }
    __syncthreads();
    if (w < 2) {
        const int h = 4 * w + hq; const size_t m = (size_t)MP + 4 * b + t_q;
        const float tot = xch[t_q * 8] + xch[t_q * 8 + 1]; const float ra = 1.0f / sqrtf(tot * (1.0f / 512.0f) + EPS);
#pragma unroll
        for (int d0 = 0; d0 < 4; ++d0) { const int col = h * 64 + 16 * d0 + 4 * g; const f32x4 gn = *(const GAS f32x4*)(F.in[14] + col); const f32x4 v = o[d0] * ra * gn;
            v2u pk; pk.x = cvtpk(v[0], v[1]); pk.y = cvtpk(v[2], v[3]); *(GAS v2u*)(AO + m * DM + col) = pk; }
    }
    {
        const float ggc = F.in[15][c];
#pragma unroll
        for (int t = 0; t < 4; ++t) { const size_t m = (size_t)MP + 4 * b + t; float tot = 0.f;
#pragma unroll
            for (int k = 0; k < 8; ++k) tot += xch2[t * 8 + k];
            const float rg = 1.0f / sqrtf(tot * (1.0f / 512.0f) + EPS); AO[m * DM + 512 + c] = (bf16)f2bf(yg[t] * rg * ggc); }
    }
    __syncthreads();
}

__device__ __forceinline__ void p8_final(Frame& F) {
    const int gw = F.vcu * NWAVES + F.wave, NGW = F.G * NWAVES; const float* ss3 = (const float*)(F.ws + WS_SS3); const GAS f32x4* gr = (const GAS f32x4*)F.in[21] + F.lane;
    f32x4 gn[4];
#pragma unroll
    for (int j = 0; j < 4; ++j) gn[j] = gr[64 * j];
    for (int m = gw; m < M; m += NGW) {
        const f32x4 p0 = *(const GAS f32x4*)(ss3 + (size_t)m * 16), p1 = *(const GAS f32x4*)(ss3 + (size_t)m * 16 + 4), p2 = *(const GAS f32x4*)(ss3 + (size_t)m * 16 + 8), p3 = *(const GAS f32x4*)(ss3 + (size_t)m * 16 + 12);
        const float tot = (((p0[0] + p0[1]) + (p0[2] + p0[3])) + ((p1[0] + p1[1]) + (p1[2] + p1[3]))) + (((p2[0] + p2[1]) + (p2[2] + p2[3])) + ((p3[0] + p3[1]) + (p3[2] + p3[3])));
        const float rs = 1.0f / sqrtf(tot * (1.0f / DM) + EPS);
        GAS f32x4* xr = (GAS f32x4*)(F.out + (size_t)m * DM) + F.lane;
#pragma unroll
        for (int j = 0; j < 4; ++j) xr[64 * j] = xr[64 * j] * rs * gn[j];
    }
}

struct Args { const float* in[22]; float* out; unsigned char* ws; int ph_lo, ph_hi, li, pad; };
__global__ void __launch_bounds__(NWAVES * 64, 2) mk_fwd(Args args) {
    extern __shared__ __attribute__((aligned(16))) unsigned char lds[];
    Frame F;
    F.lds = (LAS unsigned char*)lds;
    F.MISC = (volatile LAS unsigned*)(F.lds + MISC_OFF);
    F.tid = threadIdx.x; F.lane = F.tid & 63; F.wave = __builtin_amdgcn_readfirstlane(F.tid >> 6);
    F.G = gridDim.x; { const int bx = blockIdx.x; F.vcu = (F.G % 8 == 0) ? (bx % 8) * (F.G / 8) + bx / 8 : bx; }
    unsigned char* ws = args.ws; F.ws = ws; F.out = args.out;
    F.ctl = (gu32*)(ws + WS_CTL);
#pragma unroll
    for (int i = 0; i < 22; ++i) F.in[i] = args.in[i];
    for (int u = F.tid; u < (LDS_BYTES - LDSCTL_OFF) / 4; u += NWAVES * 64) ((LAS unsigned*)(F.lds + LDSCTL_OFF))[u] = 0u;
    __syncthreads();
    XcdBarrier bar; bar.bar = (unsigned*)(F.ctl + CW_BAR); bar.x = 0; bar.st = nullptr;
    if (N_LAUNCHES == 1) bar = xcd_barrier_post((unsigned*)(F.ctl + CW_BAR), F.MISC + 8);
#define GRID_BAR() do { if (N_LAUNCHES == 1) xcd_barrier(bar); } while (0)
    const int lo = args.ph_lo, hi = args.ph_hi;
#define IN(k) (lo <= (k) && (k) < hi)
#define BOTH(k) (IN(k) && IN((k) + 1))
    bf16* XB = (bf16*)(ws + WS_XB); bf16* HB = (bf16*)(ws + WS_H); bf16* ZB = (bf16*)(ws + WS_Z); bf16* AO = (bf16*)(ws + WS_AO);
    float* SS1 = (float*)(ws + WS_SS1); float* SS2 = (float*)(ws + WS_SS2); float* SS3 = (float*)(ws + WS_SS3); float* SSV = (float*)(ws + WS_SSV);
    float* X = F.out + O_Y;

    if (IN(0)) { p0_prologue(F);
#if PROBE == 5
        GRID_BAR(); p0_prologue(F);
#endif
        if (BOTH(0)) GRID_BAR(); }
    if (IN(1)) {
        pg8::Gemm g{XB, (const bf16*)(ws + WS_WGU1), M, NGU, DM}; pg8::StaticOrder S; S.init(M, NGU, F.G, (int)blockIdx.x);
        pg8::EpiSwiGLU<false> E{HB, FF, nullptr};
        pg8::gemm_phase<pg8::EpiSwiGLU<false>, pg8::StaticOrder, PG8_ALIGN, PG8_SP2>(F.lds + RING_OFF, g, S, E);
#if PROBE == 1
        GRID_BAR(); pg8::gemm_phase<pg8::EpiSwiGLU<false>, pg8::StaticOrder, PG8_ALIGN, PG8_SP2>(F.lds + RING_OFF, g, S, E);
#endif
        if (BOTH(1)) GRID_BAR();
    }
    if (IN(2)) {
        pg8::Gemm g{HB, (const bf16*)(ws + WS_WD1), MP, DM, FF}; pg8::StaticOrder S; S.init(MP, DM, F.G, (int)blockIdx.x);
        pg8::EpiRes<0, false, true> E{F.in[0], F.in[1] - (size_t)MP * DM, MP / 256, nullptr, XB, SS1, 0.5f};
        pg8::gemm_phase<pg8::EpiRes<0, false, true>, pg8::StaticOrder, PG8_ALIGN, PG8_SP2>(F.lds + RING_OFF, g, S, E);
        for (int t = F.vcu; t < 256; t += F.G) mini_gemm<FF>(F.lds + RING_OFF, HB + (size_t)MP * FF, (const bf16*)(ws + WS_WD1), MP, t, E, F.tid, F.wave, F.lane);
#if PROBE == 2
        GRID_BAR(); pg8::gemm_phase<pg8::EpiRes<0, false, true>, pg8::StaticOrder, PG8_ALIGN, PG8_SP2>(F.lds + RING_OFF, g, S, E);
#endif
#if PROBE == 3
        GRID_BAR(); for (int t = F.vcu; t < 256; t += F.G) mini_gemm<FF>(F.lds + RING_OFF, HB + (size_t)MP * FF, (const bf16*)(ws + WS_WD1), MP, t, E, F.tid, F.wave, F.lane);
#endif
        if (BOTH(2)) GRID_BAR();
    }
    if (IN(3)) {
        pg8::Gemm g{XB, (const bf16*)(ws + WS_WIN), M, DIN, DM}; pg8::StaticOrder S; S.init(M, DIN, F.G, (int)blockIdx.x);
        pg8::EpiInProj E{ZB, SS1, (const float*)(ws + WS_ROPE), SSV, F.out, (long)O_KP, (long)O_KS, (long)(O_VP - O_KP), (long)(O_VS - O_KS)};
        pg8::gemm_phase<pg8::EpiInProj, pg8::StaticOrder, PG8_ALIGN, PG8_SP2>(F.lds + RING_OFF, g, S, E);
#if PROBE == 7
        GRID_BAR(); pg8::gemm_phase<pg8::EpiInProj, pg8::StaticOrder, PG8_ALIGN, PG8_SP2>(F.lds + RING_OFF, g, S, E);
#endif
        if (BOTH(3)) GRID_BAR();
    }
    if (IN(4)) {
        for (int u = F.vcu; u < 128; u += F.G) p4_sample_unit(F, u);
        for (int u = F.vcu; u < 256; u += F.G) p4_attn_unit(F, u >> 6, u & 63);
        for (int u = F.vcu; u < 256; u += F.G) p4_gmlp_unit(F, u >> 6, u & 63);
#if PROBE == 6
        GRID_BAR();
        for (int u = F.vcu; u < 128; u += F.G) p4_sample_unit(F, u);
        for (int u = F.vcu; u < 256; u += F.G) p4_attn_unit(F, u >> 6, u & 63);
        for (int u = F.vcu; u < 256; u += F.G) p4_gmlp_unit(F, u >> 6, u & 63);
#endif
#if PROBE == 8
        GRID_BAR();
        for (int u = F.vcu; u < 256; u += F.G) p4_attn_unit(F, u >> 6, u & 63);
#endif
#if PROBE == 9
        GRID_BAR();
        for (int u = F.vcu; u < 256; u += F.G) p4_gmlp_unit(F, u >> 6, u & 63);
#endif
        if (BOTH(4)) GRID_BAR();
    }
    if (IN(5)) {
        pg8::Gemm g{AO, (const bf16*)(ws + WS_WOUT), MP, DM, DM}; pg8::StaticOrder S; S.init(MP, DM, F.G, (int)blockIdx.x);
        pg8::EpiRes<1, false, true> E{nullptr, nullptr, 1 << 30, nullptr, XB, SS2, 1.0f};
        pg8::gemm_phase<pg8::EpiRes<1, false, true>, pg8::StaticOrder, PG8_ALIGN, PG8_SP2>(F.lds + RING_OFF, g, S, E);
        for (int t = F.vcu; t < 256; t += F.G) mini_gemm<DM>(F.lds + RING_OFF, AO + (size_t)MP * DM, (const bf16*)(ws + WS_WOUT), MP, t, E, F.tid, F.wave, F.lane);
        if (BOTH(5)) GRID_BAR();
    }
    if (IN(6)) {
        pg8::Gemm g{XB, (const bf16*)(ws + WS_WGU2), M, NGU, DM}; pg8::StaticOrder S; S.init(M, NGU, F.G, (int)blockIdx.x);
        pg8::EpiSwiGLU<true> E{HB, FF, SS2};
        pg8::gemm_phase<pg8::EpiSwiGLU<true>, pg8::StaticOrder, PG8_ALIGN, PG8_SP2>(F.lds + RING_OFF, g, S, E);
        if (BOTH(6)) GRID_BAR();
    }
    if (IN(7)) {
        pg8::Gemm g{HB, (const bf16*)(ws + WS_WD2), MP, DM, FF}; pg8::StaticOrder S; S.init(MP, DM, F.G, (int)blockIdx.x);
        pg8::EpiRes<1, true, false> E{nullptr, nullptr, 1 << 30, X, XB, SS3, 0.5f};
        pg8::gemm_phase<pg8::EpiRes<1, true, false>, pg8::StaticOrder, PG8_ALIGN, PG8_SP2>(F.lds + RING_OFF, g, S, E);
        for (int t = F.vcu; t < 256; t += F.G) mini_gemm<FF>(F.lds + RING_OFF, HB + (size_t)MP * FF, (const bf16*)(ws + WS_WD2), MP, t, E, F.tid, F.wave, F.lane);
        if (BOTH(7)) GRID_BAR();
    }
    if (IN(8)) p8_final(F);
#undef IN
#undef BOTH
}

extern "C" void kernel_launch(void* const* d_in, const int* in_sizes, int n_in, void* d_out, int out_size, void* d_ws, size_t ws_size, hipStream_t stream) {
    static int grid = 0;
    if (grid == 0) {
        if (n_in != 22 || in_sizes[0] != MP * DM || out_size != (int)O_END || ws_size < WS_END) { fprintf(stderr, "kernel_launch: unexpected shapes (n_in %d, in0 %d, out %d, ws %zu); nothing launched\n", n_in, n_in > 0 ? in_sizes[0] : -1, out_size, ws_size); grid = -1; return; }
        int dev = 0, cus = 0, per_cu = 0;
        if (hipGetDevice(&dev) != hipSuccess || hipDeviceGetAttribute(&cus, hipDeviceAttributeMultiprocessorCount, dev) != hipSuccess) { fprintf(stderr, "kernel_launch: device query failed\n"); grid = -1; return; }
        if (hipFuncSetAttribute((const void*)mk_fwd, hipFuncAttributeMaxDynamicSharedMemorySize, LDS_BYTES) != hipSuccess) { fprintf(stderr, "kernel_launch: hipFuncSetAttribute failed\n"); grid = -1; return; }
        if (hipOccupancyMaxActiveBlocksPerMultiprocessor(&per_cu, (const void*)mk_fwd, NWAVES * 64, LDS_BYTES) != hipSuccess || per_cu < 1) { fprintf(stderr, "kernel_launch: occupancy query reports %d workgroups per CU\n", per_cu); grid = -1; (void)hipGetLastError(); return; }
        (void)hipGetLastError();
        grid = cus;
    }
    if (grid < 0) return;
    if (hipMemsetAsync((char*)d_ws + WS_CTL, 0, CTL_ZERO_BYTES, stream) != hipSuccess) { fprintf(stderr, "kernel_launch: hipMemsetAsync failed\n"); return; }
    Args a{};
    for (int i = 0; i < 22; ++i) a.in[i] = (const float*)d_in[i];
    a.out = (float*)d_out; a.ws = (unsigned char*)d_ws;
    for (int li = 0; li < N_LAUNCHES; ++li) {
        a.ph_lo = (N_LAUNCHES == 1) ? 0 : li; a.ph_hi = (N_LAUNCHES == 1) ? N_PHASES : li + 1; a.li = li;
        hipLaunchKernelGGL(mk_fwd, dim3(grid), dim3(NWAVES * 64), LDS_BYTES, stream, a);
        const hipError_t le = hipPeekAtLastError();
        if (le != hipSuccess) { fprintf(stderr, "kernel_launch: launch %d failed: %s\n", li, hipGetErrorName(le)); break; }
    }
}
```

```cpp
#include <hip/hip_runtime.h>
#ifndef PROBE
#define PROBE 0
#endif
#include <cstdio>
#include <cstdint>
#include <cmath>
namespace pg8 {
#define PG8_LAS __attribute__((address_space(3)))
typedef unsigned short bf16_t;
typedef short bf16x8 __attribute__((ext_vector_type(8)));
typedef float f32x4 __attribute__((ext_vector_type(4)));
typedef unsigned u32x4 __attribute__((ext_vector_type(4)));
constexpr int BM = 256, BK = 64, HALF = 128, HTB = HALF * BK * 2  , STAGE_BYTES = 8 * HTB, NXCD = 8, WGM = 8;

__host__ __device__ __forceinline__ int lds_byte(int r, int c) { const int st = (r >> 4) * 2 + (c >> 5), rr = r & 15, cc = c & 31, ob = rr * 64 + cc * 2; return st * 1024 + (ob ^ (((ob >> 9) & 1) << 5)); }
__host__ __device__ __forceinline__ void stage_rc(int b, int& R, int& C) { const int st = b / 1024, sb = b % 1024, swz = sb ^ (((sb >> 9) & 1) << 5); R = (st >> 1) * 16 + swz / 64; C = (st & 1) * 32 + (swz % 64) / 2; }
__host__ __device__ __forceinline__ int perm32(int rho) { const int n = rho >> 4, i = rho & 15; return 8 * (i >> 2) + 4 * n + (i & 3); }

struct Unit { int pm, pn; };
struct Gemm { const bf16_t* A; const bf16_t* Bt; int M, N, K; };

struct StaticOrder {
    int nM, nN, nwg, G, c;
    __host__ __device__ void init(int M, int N, int G_, int c_) { nM = M / BM; nN = N / BM; nwg = nM * nN; G = G_; c = c_; }
    __host__ __device__ bool next(int i, Unit& u) const {
        const long L = (long)i * G + c; if (L >= nwg) return false;
        int wgid = (int)L; { const int q = nwg / NXCD, r = nwg % NXCD, xcd = wgid % NXCD, off = wgid / NXCD; wgid = (xcd < r ? xcd * (q + 1) : r * (q + 1) + (xcd - r) * q) + off; }
        const int nig = WGM * nN, gid = wgid / nig, fm = gid * WGM, gsz = (nM - fm) < WGM ? (nM - fm) : WGM;
        u.pm = fm + ((wgid % nig) % gsz); u.pn = (wgid % nig) / gsz; return true;
    }
    __device__ __forceinline__ void a_ready(const Unit&) const {}
    __device__ __forceinline__ void done(const Unit&) const {}
};

__device__ __forceinline__ unsigned cvt_pk_bf16(float lo, float hi) { unsigned r; asm volatile("v_cvt_pk_bf16_f32 %0, %1, %2" : "=v"(r) : "v"(lo), "v"(hi)); return r; }
typedef float f32x2 __attribute__((ext_vector_type(2)));
constexpr float LOG2E = 1.4426950408889634f;
constexpr float RMS_EPS = 1e-6f;
__device__ __forceinline__ float xsum4(float s) { s += __shfl_xor(s, 16); s += __shfl_xor(s, 32); return s; }
__device__ __forceinline__ float row_rscale16(const float* ss, int row, int fq) {
    const f32x4 v = *(const f32x4*)(ss + (size_t)row * 16 + 4 * fq);
    const float s = xsum4((v[0] + v[1]) + (v[2] + v[3]));
    return __builtin_amdgcn_rsqf(s * (1.0f / 1024.0f) + RMS_EPS);
}
__device__ __forceinline__ float silu_mul(float g, float u) { return g * u * __builtin_amdgcn_rcpf(1.0f + __builtin_amdgcn_exp2f(-LOG2E * g)); }
__device__ __forceinline__ float gelu_tanh(float x) {
    const float t = x * (1.0f + 0.044715f * x * x);
    return x * __builtin_amdgcn_rcpf(1.0f + __builtin_amdgcn_exp2f(-2.0f * 0.7978845608028654f * LOG2E * t));
}
__device__ __forceinline__ u32x4 pack8(const f32x4& a, const f32x4& b) { u32x4 w; w.x = cvt_pk_bf16(a[0], a[1]); w.y = cvt_pk_bf16(a[2], a[3]); w.z = cvt_pk_bf16(b[0], b[1]); w.w = cvt_pk_bf16(b[2], b[3]); return w; }

template <bool SCALED> struct EpiSwiGLU {
    static constexpr bool PERM = true, AFTER_DRAIN = false, IS_INPROJ = false, IS_SWIGLU = !SCALED;
    bf16_t* H; int ldh; const float* ss;
    __device__ __forceinline__ void operator()(const f32x4 (&acc)[2][2][4][2], const Unit& u, int wr, int wc, int fr, int fq) const {
        const int row0 = u.pm * BM + wr * 64 + fr, col0 = u.pn * HALF + wc * 32 + 8 * fq;
        float rsv[2][4];
#pragma unroll
        for (int ai = 0; ai < 2; ++ai)
#pragma unroll
            for (int m = 0; m < 4; ++m) rsv[ai][m] = SCALED ? row_rscale16(ss, row0 + ai * HALF + m * 16, fq) : 1.0f;
#pragma unroll
        for (int ai = 0; ai < 2; ++ai)
#pragma unroll
            for (int m = 0; m < 4; ++m) { const int row = row0 + ai * HALF + m * 16;
                const float rs = rsv[ai][m];
                f32x4 h[2];
#pragma unroll
                for (int n = 0; n < 2; ++n) { const f32x4 g = acc[ai][0][m][n] * rs, v = acc[ai][1][m][n] * rs;
#pragma unroll
                    for (int i = 0; i < 4; ++i) h[n][i] = silu_mul(g[i], v[i]); }
                *(u32x4*)(H + (size_t)row * ldh + col0) = pack8(h[0], h[1]); }
    }
};

template <int RES, bool WX, bool WB> struct EpiRes {
    static constexpr bool PERM = true, AFTER_DRAIN = false, IS_INPROJ = false, IS_SWIGLU = false;
    const float* res_p; const float* res_s;
    int split_pm; float* X; bf16_t* XB; float* ss; float scale; const bf16_t* RB;
    __device__ __forceinline__ float apply4(int row, int col, const f32x4& v) const {
        typedef unsigned u32x2_ __attribute__((ext_vector_type(2)));
        const size_t off = (size_t)row * 1024 + col; f32x4 r;
        if (RES == 0) r = *(const f32x4*)(res_s + off);
        else { const u32x2_ w = *(const u32x2_*)(RB + off); r = (f32x4){__builtin_bit_cast(float, w.x << 16), __builtin_bit_cast(float, w.x & 0xffff0000u), __builtin_bit_cast(float, w.y << 16), __builtin_bit_cast(float, w.y & 0xffff0000u)}; }
        const f32x4 o = r + v * scale;
        if (WX) *(f32x4*)(X + off) = o;
        if (WB) { u32x2_ w; w.x = cvt_pk_bf16(o[0], o[1]); w.y = cvt_pk_bf16(o[2], o[3]); *(u32x2_*)(XB + off) = w; }
        return (o[0] * o[0] + o[1] * o[1]) + (o[2] * o[2] + o[3] * o[3]);
    }
    __device__ __forceinline__ void operator()(const f32x4 (&acc)[2][2][4][2], const Unit& u, int wr, int wc, int fr, int fq) const {
        const int row0 = u.pm * BM + wr * 64 + fr, col0 = u.pn * BM + wc * 32 + 8 * fq;
        const float* rb = (u.pm < split_pm) ? res_p : res_s;
#pragma unroll
        for (int ai = 0; ai < 2; ++ai)
#pragma unroll
            for (int m = 0; m < 4; ++m) { const int row = row0 + ai * HALF + m * 16; const size_t off = (size_t)row * 1024 + col0; float q = 0.f;
#pragma unroll
                for (int bj = 0; bj < 2; ++bj) {
                    f32x4 r0, r1;
                    if (RES == 0) { r0 = *(const f32x4*)(rb + off + bj * HALF); r1 = *(const f32x4*)(rb + off + bj * HALF + 4); }
                    else { const u32x4 w = *(const u32x4*)(RB + off + bj * HALF);
                        r0 = (f32x4){__builtin_bit_cast(float, w.x << 16), __builtin_bit_cast(float, w.x & 0xffff0000u), __builtin_bit_cast(float, w.y << 16), __builtin_bit_cast(float, w.y & 0xffff0000u)};
                        r1 = (f32x4){__builtin_bit_cast(float, w.z << 16), __builtin_bit_cast(float, w.z & 0xffff0000u), __builtin_bit_cast(float, w.w << 16), __builtin_bit_cast(float, w.w & 0xffff0000u)}; }
                    const f32x4 o0 = r0 + acc[ai][bj][m][0] * scale, o1 = r1 + acc[ai][bj][m][1] * scale;
                    q += (o0[0] * o0[0] + o0[1] * o0[1]) + (o0[2] * o0[2] + o0[3] * o0[3]); q += (o1[0] * o1[0] + o1[1] * o1[1]) + (o1[2] * o1[2] + o1[3] * o1[3]);
                    if (WX) { *(f32x4*)(X + off + bj * HALF) = o0; *(f32x4*)(X + off + bj * HALF + 4) = o1; }
                    if (WB) *(u32x4*)(XB + off + bj * HALF) = pack8(o0, o1); }
                q = xsum4(q);
                if (fq == 0) ss[(size_t)row * 16 + u.pn * 4 + wc] = q; }
    }
};

struct EpiInProj {
    static constexpr bool PERM = true, AFTER_DRAIN = false, IS_INPROJ = true, IS_SWIGLU = false;
    bf16_t* Z; const float* ss1; const float* rope; float* ssv; float* outb; long o_kp, o_ks, d_p, d_s;
    __device__ __forceinline__ void operator()(const f32x4 (&acc)[2][2][4][2], const Unit& u, int wr, int wc, int fr, int fq) const {
        const int row0 = u.pm * BM + wr * 64 + fr, pn = u.pn, cb = pn * BM + wc * 64 + 8 * fq;
        const bool rot = (pn < 2) || (pn == 2 && wc < 2);
        float rsv[2][4];
#pragma unroll
        for (int ai = 0; ai < 2; ++ai)
#pragma unroll
            for (int m = 0; m < 4; ++m) rsv[ai][m] = row_rscale16(ss1, row0 + ai * HALF + m * 16, fq);
#pragma unroll
        for (int ai = 0; ai < 2; ++ai)
#pragma unroll
            for (int m = 0; m < 4; ++m) { const int row = row0 + ai * HALF + m * 16;
                const float rs = rsv[ai][m];
                f32x4 a0 = acc[ai][0][m][0] * rs, a1 = acc[ai][0][m][1] * rs, b0 = acc[ai][1][m][0] * rs, b1 = acc[ai][1][m][1] * rs;
                if (rot) {
                    const int pi = (row < 16384) ? (row & 4095) : (4096 + (row & 3));
                    const float* ct = rope + (size_t)pi * 64 + 8 * fq;
                    const f32x4 c0 = *(const f32x4*)(ct), c1 = *(const f32x4*)(ct + 4), s0 = *(const f32x4*)(ct + 32), s1 = *(const f32x4*)(ct + 36);
                    const f32x4 x0 = a0 * c0 - b0 * s0, x1 = a1 * c1 - b1 * s1, y0 = b0 * c0 + a0 * s0, y1 = b1 * c1 + a1 * s1;
                    a0 = x0; a1 = x1; b0 = y0; b1 = y1;
                    if (pn < 2) { const float qs = 0.125f * LOG2E; a0 = a0 * qs; a1 = a1 * qs; b0 = b0 * qs; b1 = b1 * qs; }
                } else if (pn >= 3) {
#pragma unroll
                    for (int i = 0; i < 4; ++i) { a0[i] = gelu_tanh(a0[i]); a1[i] = gelu_tanh(a1[i]); b0[i] = gelu_tanh(b0[i]); b1[i] = gelu_tanh(b1[i]); }
                    if (pn >= 5) {
                        float q = (a0[0] * a0[0] + a0[1] * a0[1]) + (a0[2] * a0[2] + a0[3] * a0[3]); q += (a1[0] * a1[0] + a1[1] * a1[1]) + (a1[2] * a1[2] + a1[3] * a1[3]);
                        q += (b0[0] * b0[0] + b0[1] * b0[1]) + (b0[2] * b0[2] + b0[3] * b0[3]); q += (b1[0] * b1[0] + b1[1] * b1[1]) + (b1[2] * b1[2] + b1[3] * b1[3]);
                        q = xsum4(q);
                        if (fq == 0) ssv[(size_t)row * 8 + (pn - 5) * 4 + wc] = q; }
                }
                if (pn == 2) {
                    const bool smp = (u.pm >= 64); float* ob = outb + (smp ? o_ks : o_kp) + ((wc >= 2) ? (smp ? d_s : d_p) : 0); const int kvh = wc & 1; bool wr_ = false; size_t o = 0;
                    if (u.pm >= 64) { const int bs = (row - 16384) >> 2, t = row & 3; o = ((size_t)(bs * 128 + 124 + t) * 2 + kvh) * 64 + 8 * fq; wr_ = true; }
                    else if ((u.pm & 15) == 15 && ai == 1) { const int bp = row >> 12, t = (row & 4095) - 3968; o = ((size_t)(bp * 128 + t) * 2 + kvh) * 64 + 8 * fq; wr_ = true; }
                    if (wr_) { *(f32x4*)(ob + o) = a0; *(f32x4*)(ob + o + 4) = a1; *(f32x4*)(ob + o + 32) = b0; *(f32x4*)(ob + o + 36) = b1; }
                }
                bf16_t* zr = Z + (size_t)row * 1792 + cb;
                *(u32x4*)(zr) = pack8(a0, a1); *(u32x4*)(zr + 32) = pack8(b0, b1); }
    }
};
template <class Epi, class Sched, bool ALIGN_EPI = false, bool SP2 = false>
__device__ __forceinline__ void gemm_phase(PG8_LAS unsigned char* lds, const Gemm g, const Sched& S, const Epi& E) {
    const int tid = threadIdx.x, wid = __builtin_amdgcn_readfirstlane(tid >> 6), lane = tid & 63, wr = wid >> 2, wc = wid & 3, fr = lane & 15, fq = lane >> 4;
    const int K = g.K, nt = K / BK;
    unsigned voffA[2], voffB[2];
#pragma unroll
    for (int i = 0; i < 2; ++i) { int R, C; stage_rc(tid * 16 + i * 8192, R, C); const int Rb = Epi::PERM ? ((R & ~31) + perm32(R & 31)) : R;
        voffA[i] = (unsigned)(R * K + C) * 2u; voffB[i] = (unsigned)(Rb * K + C) * 2u; }
    const size_t kstep = (size_t)(BK * 2);
    const size_t hstep = (size_t)HALF * K * 2;
    const size_t tstep = 2 * hstep;
    const unsigned ldsw = (unsigned)wid * 1024u;
    const int aoff = lds_byte(wr * 64 + fr, fq * 8), boff = lds_byte(wc * 32 + fr, fq * 8);
#define PG8_SA(b, h) (((b) * 2 + (h)) * HTB)
#define PG8_SB(b, h) ((4 + (b) * 2 + (h)) * HTB)
#define PG8_STAGE(bufoff, gbase, voff) do { _Pragma("unroll") for (int _i = 0; _i < 2; ++_i) \
        __builtin_amdgcn_global_load_lds((const unsigned*)((const char*)(gbase) + (voff)[_i]), (PG8_LAS unsigned*)(lds + (bufoff) + ldsw + _i * 8192), 16, 0, 0); } while (0)
#define PG8_LDA(dst, b, h) do { _Pragma("unroll") for (int m = 0; m < 4; ++m) _Pragma("unroll") for (int k = 0; k < 2; ++k) dst[m][k] = *(const PG8_LAS bf16x8*)(lds + PG8_SA(b, h) + aoff + m * 2048 + k * 1024); } while (0)
#define PG8_LDB(dst, b, h) do { _Pragma("unroll") for (int n = 0; n < 2; ++n) _Pragma("unroll") for (int k = 0; k < 2; ++k) dst[n][k] = *(const PG8_LAS bf16x8*)(lds + PG8_SB(b, h) + boff + n * 2048 + k * 1024); } while (0)
#define PG8_MMA(ai, bj, At, Bt) do { __builtin_amdgcn_s_setprio(1); _Pragma("unroll") for (int m = 0; m < 4; ++m) _Pragma("unroll") for (int n = 0; n < 2; ++n) _Pragma("unroll") for (int k = 0; k < 2; ++k) \
        acc[ai][bj][m][n] = __builtin_amdgcn_mfma_f32_16x16x32_bf16(Bt[n][k], At[m][k], acc[ai][bj][m][n], 0, 0, 0); __builtin_amdgcn_s_setprio(0); } while (0)
#define PG8_WAIT_V(n) asm volatile("s_waitcnt vmcnt(" #n ")" ::: "memory")
#define PG8_WAIT_L(n) asm volatile("s_waitcnt lgkmcnt(" #n ")" ::: "memory")
#define PG8_BAR __builtin_amdgcn_s_barrier()
#define PG8_SCHED __builtin_amdgcn_sched_barrier(0)
    Unit cur, nxt; int ui = 0;
    if (!S.next(0, cur)) return;
    f32x4 acc[2][2][4][2];
#pragma unroll
    for (int a = 0; a < 2; ++a)
#pragma unroll
        for (int b = 0; b < 2; ++b)
#pragma unroll
            for (int m = 0; m < 4; ++m)
#pragma unroll
                for (int n = 0; n < 2; ++n) acc[a][b][m][n] = (f32x4){0.f, 0.f, 0.f, 0.f};
    bf16x8 At[4][2], B0[2][2], B1[2][2];
    const char* cA = (const char*)g.A + (size_t)cur.pm * tstep; const char* cB = (const char*)g.Bt + (size_t)cur.pn * tstep;
    S.a_ready(cur);
    if constexpr (SP2) {
        PG8_STAGE(PG8_SB(0, 0), cB, voffB); PG8_STAGE(PG8_SB(0, 1), cB + hstep, voffB); PG8_STAGE(PG8_SA(0, 0), cA, voffA); PG8_STAGE(PG8_SA(0, 1), cA + hstep, voffA);
        if (wr == 1) PG8_BAR;
        PG8_WAIT_V(2); PG8_BAR;
        PG8_STAGE(PG8_SB(1, 0), cB + kstep, voffB); PG8_STAGE(PG8_SA(1, 0), cA + kstep, voffA); PG8_STAGE(PG8_SB(1, 1), cB + hstep + kstep, voffB);
        PG8_WAIT_V(6); PG8_BAR;
    } else {
        PG8_STAGE(PG8_SB(0, 0), cB, voffB); PG8_STAGE(PG8_SA(0, 0), cA, voffA); PG8_STAGE(PG8_SB(0, 1), cB + hstep, voffB); PG8_STAGE(PG8_SA(0, 1), cA + hstep, voffA);
        if (wr == 1) PG8_BAR;
        PG8_WAIT_V(4); PG8_BAR;
        PG8_STAGE(PG8_SB(1, 0), cB + kstep, voffB); PG8_STAGE(PG8_SA(1, 0), cA + kstep, voffA); PG8_STAGE(PG8_SB(1, 1), cB + hstep + kstep, voffB);
        PG8_WAIT_V(6); PG8_BAR;
    }
    for (;;) {
        const bool has_next = S.next(ui + 1, nxt);
        const char* nA = has_next ? (const char*)g.A + (size_t)nxt.pm * tstep : cA; const char* nB = has_next ? (const char*)g.Bt + (size_t)nxt.pn * tstep : cB;
        for (int t = 0; t < nt; t += 2) {
            const bool last = (t == nt - 2);
            const char* a1 = cA + (size_t)(t + 1) * kstep;
            const char* a2 = last ? nA : cA + (size_t)(t + 2) * kstep; const char* b2 = last ? nB : cB + (size_t)(t + 2) * kstep;
            const char* a3 = a2 + kstep; const char* b3 = b2 + kstep;
            if (last && has_next) S.a_ready(nxt);
            if constexpr (SP2) {
            PG8_LDB(B0, 0, 0); PG8_LDB(B1, 0, 1); PG8_SCHED; PG8_LDA(At, 0, 0); PG8_STAGE(PG8_SA(1, 1), a1 + hstep, voffA);
            PG8_WAIT_V(8); PG8_WAIT_L(0); PG8_BAR; PG8_MMA(0, 0, At, B0); PG8_MMA(0, 1, At, B1); PG8_BAR; PG8_SCHED;
            PG8_LDA(At, 0, 1); PG8_STAGE(PG8_SB(0, 0), b2, voffB); PG8_STAGE(PG8_SB(0, 1), b2 + hstep, voffB); PG8_STAGE(PG8_SA(0, 0), a2, voffA);
            PG8_WAIT_V(8); PG8_WAIT_L(0); PG8_BAR; PG8_MMA(1, 0, At, B0); PG8_MMA(1, 1, At, B1); PG8_BAR; PG8_SCHED;
            PG8_LDB(B0, 1, 0); PG8_LDB(B1, 1, 1); PG8_SCHED; PG8_LDA(At, 1, 0); PG8_STAGE(PG8_SA(0, 1), a2 + hstep, voffA);
            PG8_WAIT_V(8); PG8_WAIT_L(0); PG8_BAR; PG8_MMA(0, 0, At, B0); PG8_MMA(0, 1, At, B1); PG8_BAR; PG8_SCHED;
            PG8_LDA(At, 1, 1); PG8_STAGE(PG8_SB(1, 0), b3, voffB); PG8_STAGE(PG8_SB(1, 1), b3 + hstep, voffB); PG8_STAGE(PG8_SA(1, 0), a3, voffA);
            PG8_WAIT_V(8); PG8_WAIT_L(0); PG8_BAR; PG8_MMA(1, 0, At, B0); PG8_MMA(1, 1, At, B1); PG8_BAR; PG8_SCHED;
            } else {
            PG8_LDB(B0, 0, 0); PG8_SCHED; PG8_LDA(At, 0, 0); PG8_STAGE(PG8_SA(1, 1), a1 + hstep, voffA);
            PG8_WAIT_L(8); PG8_BAR; PG8_WAIT_L(0); PG8_MMA(0, 0, At, B0); PG8_BAR; PG8_SCHED;
            PG8_LDB(B1, 0, 1); PG8_STAGE(PG8_SB(0, 0), b2, voffB);
            PG8_BAR; PG8_WAIT_L(0); PG8_MMA(0, 1, At, B1); PG8_BAR;
            PG8_LDA(At, 0, 1); PG8_STAGE(PG8_SA(0, 0), a2, voffA);
            PG8_BAR; PG8_WAIT_L(0); PG8_MMA(1, 0, At, B0); PG8_BAR; PG8_SCHED;
            PG8_STAGE(PG8_SB(0, 1), b2 + hstep, voffB);
            PG8_WAIT_V(6); PG8_BAR; PG8_MMA(1, 1, At, B1); PG8_BAR;
            PG8_LDB(B0, 1, 0); PG8_SCHED; PG8_LDA(At, 1, 0); PG8_STAGE(PG8_SA(0, 1), a2 + hstep, voffA);
            PG8_WAIT_L(8); PG8_BAR; PG8_WAIT_L(0); PG8_MMA(0, 0, At, B0); PG8_BAR; PG8_SCHED;
            PG8_LDB(B1, 1, 1); PG8_STAGE(PG8_SB(1, 0), b3, voffB);
            PG8_BAR; PG8_WAIT_L(0); PG8_MMA(0, 1, At, B1); PG8_BAR;
            PG8_LDA(At, 1, 1); PG8_STAGE(PG8_SA(1, 0), a3, voffA);
            PG8_BAR; PG8_WAIT_L(0); PG8_MMA(1, 0, At, B0); PG8_BAR; PG8_SCHED;
            PG8_STAGE(PG8_SB(1, 1), b3 + hstep, voffB);
            PG8_WAIT_V(6); PG8_BAR; PG8_MMA(1, 1, At, B1); PG8_BAR;
            }
        }
        if constexpr (ALIGN_EPI) { if (wr == 0) PG8_BAR; }
#if PROBE == 4
        if constexpr (!Epi::AFTER_DRAIN) { E(acc, cur, wr, wc, fr, fq); asm volatile("" ::: "memory"); }
#endif
#if PROBE == 16
        if constexpr (Epi::IS_INPROJ) { E(acc, cur, wr, wc, fr, fq); asm volatile("" ::: "memory"); }
#endif
#if PROBE == 17
        if constexpr (Epi::IS_SWIGLU) { E(acc, cur, wr, wc, fr, fq); asm volatile("" ::: "memory"); E(acc, cur, wr, wc, fr, fq); asm volatile("" ::: "memory"); }
#endif
        if constexpr (!Epi::AFTER_DRAIN) { E(acc, cur, wr, wc, fr, fq); S.done(cur); }
        if (!has_next) break;
#pragma unroll
        for (int a = 0; a < 2; ++a)
#pragma unroll
            for (int b = 0; b < 2; ++b)
#pragma unroll
                for (int m = 0; m < 4; ++m)
#pragma unroll
                    for (int n = 0; n < 2; ++n) acc[a][b][m][n] = (f32x4){0.f, 0.f, 0.f, 0.f};
        cur = nxt; cA = nA; cB = nB; ++ui;
        if constexpr (ALIGN_EPI) { if (wr == 1) PG8_BAR; }
    }
    PG8_WAIT_V(0);
    if constexpr (!ALIGN_EPI) { if (wr == 0) PG8_BAR; }
    PG8_BAR;
    if constexpr (Epi::AFTER_DRAIN) { E.fused(acc, cur, wr, wc, fr, fq, lds, wid, lane); S.done(cur); }
#undef PG8_SA
#undef PG8_SB
#undef PG8_STAGE
#undef PG8_LDA
#undef PG8_LDB
#undef PG8_MMA
#undef PG8_WAIT_V
#undef PG8_WAIT_L
#undef PG8_BAR
#undef PG8_SCHED
}
}

#ifndef PG8_SP2
#define PG8_SP2 true
#endif
#ifndef PG8_ALIGN
#define PG8_ALIGN true
#endif
#ifndef MK_N_LAUNCHES
#define MK_N_LAUNCHES 1
#endif
constexpr int NWAVES = 8;
constexpr int N_PHASES = 9;
constexpr int N_LAUNCHES = MK_N_LAUNCHES;
constexpr int DM = 1024, FF = 2816, NGU = 2 * FF, DIN = 1792;
constexpr int MP = 16384, MS = 512, M = MP + MS;
constexpr int ZQ = 0, ZK = 512, ZV = 640, ZU = 768, ZG = 1280;
constexpr float EPS = 1e-6f, LOG2E_F = 1.4426950408889634f;
constexpr size_t O_Y = 0, O_KP = 17301504, O_VP = 17367040, O_KS = 17432576, O_VS = 19529728, O_GP = 21626880, O_GS = 21889024, O_END = 22151168;
constexpr size_t MiB = 1u << 20;
constexpr size_t WS_CTL = 0, CTL_ZERO_BYTES = 1 * MiB;
constexpr size_t WS_WGU1 = 1 * MiB, WS_WD1 = 12 * MiB, WS_WIN = 18 * MiB, WS_WOUT = 22 * MiB, WS_WGU2 = 24 * MiB, WS_WD2 = 35 * MiB;
constexpr size_t WS_TRIL = 41 * MiB, WS_ROPE = 42 * MiB, WS_SS1 = 44 * MiB, WS_SS2 = 46 * MiB, WS_SS3 = 48 * MiB, WS_SSV = 50 * MiB;
constexpr size_t WS_XB = 52 * MiB;
constexpr size_t WS_H = 86 * MiB;
constexpr size_t WS_Z = WS_H, WS_AO = WS_H + (size_t)M * DIN * 2;
constexpr size_t WS_END = WS_H + (size_t)M * FF * 2;
static_assert(WS_AO + (size_t)M * DM * 2 <= WS_END && WS_END <= 256 * MiB && WS_XB + (size_t)M * DM * 2 <= WS_H, "d_ws map");
static_assert(WS_WGU1 + (size_t)NGU * DM * 2 <= WS_WD1 && WS_WD1 + (size_t)DM * FF * 2 <= WS_WIN && WS_WIN + (size_t)DIN * DM * 2 <= WS_WOUT && WS_WGU2 + (size_t)NGU * DM * 2 <= WS_WD2 && WS_WD2 + (size_t)DM * FF * 2 <= WS_TRIL, "weights map");
static_assert(WS_ROPE + 4100 * 64 * 4 <= WS_SS1 && WS_SS1 + (size_t)M * 64 <= WS_SS2 && WS_SSV + (size_t)M * 32 <= WS_XB, "small tables map");
constexpr int CW_TMO = 0, CW_CODE = 1, CW_BAR = 4096;
constexpr int RING_OFF = 0, PHASE_BYTES = 139264;
constexpr int XCH_OFF = 135168;
constexpr int LDSCTL_OFF = PHASE_BYTES, MISC_OFF = LDSCTL_OFF + 320;
constexpr int LDS_BYTES = 147456;
static_assert(MISC_OFF + 128 <= LDS_BYTES && XCH_OFF + 4096 <= PHASE_BYTES, "LDS map");

#define GAS __attribute__((address_space(1)))
#define LAS __attribute__((address_space(3)))
typedef unsigned short bf16;
typedef unsigned v4u __attribute__((ext_vector_type(4)));
typedef unsigned v2u __attribute__((ext_vector_type(2)));
typedef float f32x4 __attribute__((ext_vector_type(4)));
typedef short bf16x8 __attribute__((ext_vector_type(8)));
typedef short s16x4 __attribute__((ext_vector_type(4)));
typedef GAS unsigned gu32;
typedef GAS unsigned long long gu64;
#define RLX_AGENT __ATOMIC_RELAXED, __HIP_MEMORY_SCOPE_AGENT
#define LDS_WAIT() asm volatile("s_waitcnt lgkmcnt(0)" ::: "memory")
#define VM_WAIT() asm volatile("s_waitcnt vmcnt(0)" ::: "memory")
__device__ __forceinline__ unsigned f2bf(float f) { unsigned u = __builtin_bit_cast(unsigned, f); return (u + 0x7fffu + ((u >> 16) & 1u)) >> 16; }
__device__ __forceinline__ unsigned pk2(float lo, float hi) { return f2bf(lo) | (f2bf(hi) << 16); }
__device__ __forceinline__ float bf_lo(unsigned w) { return __builtin_bit_cast(float, w << 16); }
__device__ __forceinline__ float bf_hi(unsigned w) { return __builtin_bit_cast(float, w & 0xffff0000u); }
__device__ __forceinline__ float xs4(float s) { s += __shfl_xor(s, 16); s += __shfl_xor(s, 32); return s; }
__device__ __forceinline__ float wave_sum(float v) {
#pragma unroll
    for (int o = 1; o < 64; o <<= 1) v += __shfl_xor(v, o);
    return v;
}
#define XB_TMO      128
#define XB_XCNT(j)  (256  + 64 * (j))
#define XB_XSUB(j)  (1280 + 64 * (j))
#define XB_XGEN(j)  (2304 + 64 * (j))
#define XB_TOP      3328
#define XB_TOPGEN   3392
#define XCD_BAR_WORDS 3456
#define XB_SPIN_CAP (1u << 18)

__device__ __forceinline__ unsigned xb_ld(unsigned* p)              { return __hip_atomic_load(p, __ATOMIC_RELAXED, __HIP_MEMORY_SCOPE_AGENT); }
__device__ __forceinline__ unsigned xb_add(unsigned* p, unsigned v) { return __hip_atomic_fetch_add(p, v, __ATOMIC_RELAXED, __HIP_MEMORY_SCOPE_AGENT); }
__device__ __forceinline__ unsigned xb_xcc_id() { return (unsigned)__builtin_amdgcn_s_getreg((3 << 11) | 20) & 0xFu; }
#define XB_SPIN(cond, bar) do { unsigned _sp = 0; while (cond) { __builtin_amdgcn_s_sleep(1); \
    if ((++_sp & 255u) == 0u) { if (xb_ld(&(bar)[XB_TMO])) break; if (_sp > XB_SPIN_CAP) { atomicAdd(&(bar)[XB_TMO], 1u); break; } } } } while (0)

struct XcdBarrier {
    unsigned* bar; unsigned x;
    volatile LAS unsigned* st;
};

__device__ __forceinline__ XcdBarrier xcd_barrier_post(unsigned* bar, volatile LAS unsigned* st) {
    XcdBarrier b; b.bar = bar; b.x = xb_xcc_id(); b.st = st;
    if (threadIdx.x == 0) (void)xb_add(&bar[XB_XCNT(b.x)], 1u);
    return b;
}
__device__ __forceinline__ void xcd_barrier_complete(unsigned* bar, unsigned x, unsigned& nloc, unsigned& nx) {
    const unsigned G = gridDim.x * gridDim.y * gridDim.z;
    unsigned sum, cnt, mine, sp = 0u;
    for (;;) {
        sum = 0u; cnt = 0u; mine = 0u;
#pragma unroll
        for (unsigned j = 0; j < 16; ++j) { const unsigned c = xb_ld(&bar[XB_XCNT(j)]); sum += c; cnt += (c > 0u) ? 1u : 0u; mine = (j == x) ? c : mine; }
        if (sum == G) break;
        __builtin_amdgcn_s_sleep(1);
        if ((++sp & 255u) == 0u) { if (xb_ld(&bar[XB_TMO])) break; if (sp > XB_SPIN_CAP) { atomicAdd(&bar[XB_TMO], 1u); break; } }
    }
    nloc = mine > 0u ? mine : 1u; nx = cnt > 0u ? cnt : 1u;
}

__device__ __forceinline__ void xcd_barrier(const XcdBarrier& b) {
    asm volatile("s_waitcnt vmcnt(0)" ::: "memory");
    __syncthreads();
    if (threadIdx.x == 0) {
        unsigned* bar = b.bar;
        __builtin_amdgcn_s_waitcnt(0);
        unsigned nloc = b.st[0], nx = b.st[1];
        if (nloc == 0u) { xcd_barrier_complete(bar, b.x, nloc, nx); b.st[0] = nloc; b.st[1] = nx; }
        const unsigned old = xb_add(&bar[XB_XSUB(b.x)], 1u);
        const unsigned gen = old / nloc;
        if (old + 1u == (gen + 1u) * nloc) {
            __builtin_amdgcn_fence(__ATOMIC_RELEASE, "agent");
            asm volatile("s_waitcnt vmcnt(0)" ::: "memory");
            const unsigned og = xb_add(&bar[XB_TOP], 1u);
            const unsigned tg = og / nx;
            if (og + 1u == (tg + 1u) * nx) xb_add(&bar[XB_TOPGEN], 1u);
            else XB_SPIN(xb_ld(&bar[XB_TOPGEN]) == tg, bar);
            __builtin_amdgcn_fence(__ATOMIC_ACQUIRE, "agent");
            xb_add(&bar[XB_XGEN(b.x)], 1u);
            asm volatile("s_waitcnt vmcnt(0)" ::: "memory");
        } else {
            XB_SPIN(xb_ld(&bar[XB_XGEN(b.x)]) == gen, bar);
            __builtin_amdgcn_fence(__ATOMIC_ACQUIRE, "agent");
            asm volatile("s_waitcnt vmcnt(0)" ::: "memory");
        }
    }
    __syncthreads();
}


struct Frame {
    LAS unsigned char* lds;
    volatile LAS unsigned* MISC;
    gu32* ctl;
    int tid, lane, wave;
    int vcu, G;
    const float* in[22]; float* out; unsigned char* ws; int pad;
};
__constant__ float c_inv_freq[32] = {
    1.000000000e+00f, 7.498942018e-01f, 5.623413324e-01f, 4.216965139e-01f, 3.162277639e-01f, 2.371373773e-01f, 1.778279394e-01f, 1.333521456e-01f,
    1.000000015e-01f, 7.498942316e-02f, 5.623413250e-02f, 4.216964915e-02f, 3.162277490e-02f, 2.371373773e-02f, 1.778279431e-02f, 1.333521400e-02f,
    9.999999776e-03f, 7.498942316e-03f, 5.623413250e-03f, 4.216964822e-03f, 3.162277630e-03f, 2.371373819e-03f, 1.778279431e-03f, 1.333521446e-03f,
    1.000000047e-03f, 7.498941850e-04f, 5.623413017e-04f, 4.216965172e-04f, 3.162277571e-04f, 2.371373703e-04f, 1.778279402e-04f, 1.333521504e-04f };

__device__ __forceinline__ void p0_transpose_item(const float* W, int K, int N, bf16* WT, int mode, const float* gk, LAS float* scr, int item, int lane) {
    const int nblk = N / 32, kb = item / nblk, nb = item % nblk, k0 = 64 * kb, n0 = 32 * nb;
    int rb = n0;
    if (mode == 1) rb = 256 * (n0 >> 7) + (n0 & 127);
    else if (mode == 2) rb = 256 * (n0 >> 7) + 128 + (n0 & 127);
    else if (mode == 3) rb = (n0 & ~0xE0) | (((n0 >> 5) & 1) << 7) | (((n0 >> 6) & 3) << 5);
#pragma unroll 8
    for (int i = 0; i < 32; ++i) { const int kk = 2 * i + (lane >> 5); scr[kk * 33 + (lane & 31)] = W[(size_t)(k0 + kk) * N + n0 + (lane & 31)]; }
    LDS_WAIT(); asm volatile("" ::: "memory");
    const int c = lane & 7;
    float g8[8];
#pragma unroll
    for (int e = 0; e < 8; ++e) g8[e] = gk ? gk[k0 + 8 * c + e] : 1.0f;
#pragma unroll
    for (int j = 0; j < 4; ++j) { const int n = (lane >> 3) + 8 * j; const LAS float* s = scr + (8 * c) * 33 + n;
        v4u o; o.x = pk2(s[0 * 33] * g8[0], s[1 * 33] * g8[1]); o.y = pk2(s[2 * 33] * g8[2], s[3 * 33] * g8[3]); o.z = pk2(s[4 * 33] * g8[4], s[5 * 33] * g8[5]); o.w = pk2(s[6 * 33] * g8[6], s[7 * 33] * g8[7]);
        *(GAS v4u*)(WT + (size_t)(rb + n) * K + k0 + 8 * c) = o; }
    LDS_WAIT(); asm volatile("" ::: "memory");
}
__device__ __forceinline__ void rms_row_to_bf16(int lane, const float* xrow, const float* gain, bf16* orow) {
    const GAS f32x4* xr = (const GAS f32x4*)xrow + lane; const GAS f32x4* gr = (const GAS f32x4*)gain + lane;
    f32x4 v[4]; float s = 0.f;
#pragma unroll
    for (int j = 0; j < 4; ++j) { v[j] = xr[64 * j]; s += (v[j].x * v[j].x + v[j].y * v[j].y) + (v[j].z * v[j].z + v[j].w * v[j].w); }
    const float rs = 1.0f / sqrtf(wave_sum(s) * (1.f / DM) + EPS);
    GAS unsigned long long* o8 = (GAS unsigned long long*)orow + lane;
#pragma unroll
    for (int j = 0; j < 4; ++j) { const f32x4 g = gr[64 * j]; o8[64 * j] = (unsigned long long)pk2(v[j].x * rs * g.x, v[j].y * rs * g.y) | ((unsigned long long)pk2(v[j].z * rs * g.z, v[j].w * rs * g.w) << 32); }
}
__device__ __forceinline__ void sincos_d(float ang, float& sn, float& cs) {
    const double x = (double)ang; const double kd = __builtin_rint(x * 0.63661977236758134308);
    const double r = __builtin_fma(-kd, 6.123233995736766036e-17, __builtin_fma(-kd, 1.5707963267948966192, x)); const double r2 = r * r;
    double ps = -7.6471637318198164759e-13; ps = ps * r2 + 1.6059043836821614599e-10; ps = ps * r2 - 2.5052108385441718775e-08; ps = ps * r2 + 2.7557319223985890653e-06; ps = ps * r2 - 1.9841269841269841270e-04;
    ps = ps * r2 + 8.3333333333333333333e-03; ps = ps * r2 - 1.6666666666666666667e-01; const double s = r + r * r2 * ps;
    double pc = 4.7794773323873852974e-14; pc = pc * r2 - 1.1470745597729724714e-11; pc = pc * r2 + 2.0876756987868098979e-09; pc = pc * r2 - 2.7557319223985890653e-07; pc = pc * r2 + 2.4801587301587301587e-05;
    pc = pc * r2 - 1.3888888888888888889e-03; pc = pc * r2 + 4.1666666666666666667e-02; pc = pc * r2 - 0.5; const double c = 1.0 + r2 * pc;
    const int q = (int)kd & 3;
    const double ss = (q & 1) ? c : s, cc = (q & 1) ? s : c;
    sn = (float)((q & 2) ? -ss : ss); cs = (float)(((q + 1) & 2) ? -cc : cc);
}
__device__ __forceinline__ void p0_prologue(Frame& F) {
    LAS float* scr = (LAS float*)(F.lds + RING_OFF + F.wave * 16384);
    const int gw = F.vcu * NWAVES + F.wave, NGW = F.G * NWAVES;
    bf16* Wgu1 = (bf16*)(F.ws + WS_WGU1); bf16* Wd1 = (bf16*)(F.ws + WS_WD1); bf16* Win = (bf16*)(F.ws + WS_WIN); bf16* Wout = (bf16*)(F.ws + WS_WOUT); bf16* Wgu2 = (bf16*)(F.ws + WS_WGU2); bf16* Wd2 = (bf16*)(F.ws + WS_WD2);
    constexpr int I_GU = (DM / 64) * (FF / 32), I_D = (FF / 64) * (DM / 32), I_IN = (DM / 64) * (DIN / 32), I_OUT = (DM / 64) * (DM / 32);
    constexpr int NITEMS = 4 * I_GU + 2 * I_D + I_IN + I_OUT;
    for (int it = gw; it < NITEMS; it += NGW) {
        int r = it;
        if (r < I_GU) { p0_transpose_item(F.in[5], DM, FF, Wgu1, 1, nullptr, scr, r, F.lane); continue; } r -= I_GU;
        if (r < I_GU) { p0_transpose_item(F.in[6], DM, FF, Wgu1, 2, nullptr, scr, r, F.lane); continue; } r -= I_GU;
        if (r < I_D) { p0_transpose_item(F.in[7], FF, DM, Wd1, 0, nullptr, scr, r, F.lane); continue; } r -= I_D;
        if (r < I_IN) { p0_transpose_item(F.in[9], DM, DIN, Win, 3, F.in[8], scr, r, F.lane); continue; } r -= I_IN;
        if (r < I_OUT) { p0_transpose_item(F.in[16], DM, DM, Wout, 0, nullptr, scr, r, F.lane); continue; } r -= I_OUT;
        if (r < I_GU) { p0_transpose_item(F.in[18], DM, FF, Wgu2, 1, F.in[17], scr, r, F.lane); continue; } r -= I_GU;
        if (r < I_GU) { p0_transpose_item(F.in[19], DM, FF, Wgu2, 2, F.in[17], scr, r, F.lane); continue; } r -= I_GU;
        p0_transpose_item(F.in[20], FF, DM, Wd2, 0, nullptr, scr, r, F.lane);
    }
    bf16* XB = (bf16*)(F.ws + WS_XB);
    for (int m = gw; m < M; m += NGW) { const float* xr = (m < MP) ? F.in[0] + (size_t)m * DM : F.in[1] + (size_t)(m - MP) * DM; rms_row_to_bf16(F.lane, xr, F.in[4], XB + (size_t)m * DM); }
    float* rope = (float*)(F.ws + WS_ROPE);
    const int gt = F.vcu * (NWAVES * 64) + F.tid, NGT = F.G * NWAVES * 64;
    for (int e = gt; e < 4100 * 32; e += NGT) { const int pi = e >> 5, i = e & 31; const int pos = pi < 4096 ? pi : 16384 + (pi - 4096);
        const float ang = (float)pos * c_inv_freq[i]; float sn, cs; sincos_d(ang, sn, cs); rope[pi * 64 + i] = cs; rope[pi * 64 + 32 + i] = sn; }
    bf16* tril = (bf16*)(F.ws + WS_TRIL);
    for (int e = gt; e < 8 * 128 * 128; e += NGT) { const int s = e & 127, t = (e >> 7) & 127; tril[e] = (bf16)f2bf(s <= t ? F.in[12][e] : 0.f); }
}

constexpr int KVS = 160;
constexpr int GVS = 1056;
typedef short v4i16_t __attribute__((ext_vector_type(4)));
__device__ __forceinline__ s16x4 vtr(LAS const unsigned char* p) { return __builtin_bit_cast(s16x4, __builtin_amdgcn_ds_read_tr16_b64_v4i16((LAS v4i16_t*)p)); }
__device__ __forceinline__ unsigned cvtpk(float lo, float hi) { unsigned r; asm volatile("v_cvt_pk_bf16_f32 %0, %1, %2" : "=v"(r) : "v"(lo), "v"(hi)); return r; }
#define MFMA16(a, b, c) __builtin_amdgcn_mfma_f32_16x16x32_bf16((a), (b), (c), 0, 0, 0)
template <int K, class Epi> __device__ __forceinline__ void mini_gemm(LAS unsigned char* lds, const bf16* A, const bf16* Bt, int rowbase, int tile, const Epi& E, int tid, int wave, int lane) {
    constexpr int KW = K / 8, NKS = KW / 32, CH = 4, NCH = (NKS + CH - 1) / CH; static_assert(KW % 32 == 0 && NCH <= 3, "K / 8 must be a multiple of 32");
    const int rt = tile >> 4, ct = tile & 15, g = lane >> 4, fr = lane & 15;
    const bf16* ap = A + (size_t)(rt * 32 + fr) * K + wave * KW + 8 * g;
    const bf16* bp = Bt + (size_t)(ct * 64 + fr) * K + wave * KW + 8 * g;
    f32x4 acc[2][4];
#pragma unroll
    for (int i = 0; i < 2; ++i)
#pragma unroll
        for (int c = 0; c < 4; ++c) acc[i][c] = (f32x4){0.f, 0.f, 0.f, 0.f};
    bf16x8 fa[3][CH][2], fb[3][CH][4];
#define MINI_LOAD(ch) do { _Pragma("unroll") for (int k = 0; k < CH; ++k) if ((ch) * CH + k < NKS) { \
        _Pragma("unroll") for (int i = 0; i < 2; ++i) fa[ch][k][i] = *(const GAS bf16x8*)(ap + (size_t)i * 16 * K + ((ch) * CH + k) * 32); \
        _Pragma("unroll") for (int c = 0; c < 4; ++c) fb[ch][k][c] = *(const GAS bf16x8*)(bp + (size_t)c * 16 * K + ((ch) * CH + k) * 32); } } while (0)
#define MINI_MMA(ch) do { _Pragma("unroll") for (int k = 0; k < CH; ++k) if ((ch) * CH + k < NKS) { \
        _Pragma("unroll") for (int i = 0; i < 2; ++i) _Pragma("unroll") for (int c = 0; c < 4; ++c) acc[i][c] = MFMA16(fb[ch][k][c], fa[ch][k][i], acc[i][c]); } } while (0)
    MINI_LOAD(0); if (NCH > 1) MINI_LOAD(1);
    __builtin_amdgcn_sched_barrier(0);
    MINI_MMA(0);
    if (NCH > 2) { __builtin_amdgcn_sched_barrier(0); MINI_LOAD(2); __builtin_amdgcn_sched_barrier(0); }
    if (NCH > 1) MINI_MMA(1);
    if (NCH > 2) MINI_MMA(2);
#undef MINI_LOAD
#undef MINI_MMA
    LAS f32x4* P = (LAS f32x4*)lds;
#pragma unroll
    for (int i = 0; i < 2; ++i)
#pragma unroll
        for (int c = 0; c < 4; ++c) P[((wave * 2 + i) * 4 + c) * 64 + lane] = acc[i][c];
    __syncthreads();
    const int r = tid >> 4, cg = tid & 15; const int src = (((r >> 4) * 4 + (cg >> 2)) * 64) + (r & 15) + 16 * (cg & 3);
    f32x4 sum = P[src];
#pragma unroll
    for (int w = 1; w < 8; ++w) sum = sum + P[w * 512 + src];
    float q = E.apply4(rowbase + rt * 32 + r, ct * 64 + 4 * cg, sum);
    q += __shfl_xor(q, 1); q += __shfl_xor(q, 2); q += __shfl_xor(q, 4); q += __shfl_xor(q, 8);
    if (cg == 0) E.ss[(size_t)(rowbase + rt * 32 + r) * 16 + ct] = q;
    __syncthreads();
}

template <int NF> __device__ __forceinline__ void attn_core(f32x4 (&o)[4], bf16x8 qf0, bf16x8 qf1, LAS const unsigned char* kp, LAS const unsigned char* vp, int slot0, int slot_lo, int slot_hi, float sink2) {
    f32x4 s[NF];
#pragma unroll
    for (int f = 0; f < NF; ++f) { const bf16x8 k0 = *(const LAS bf16x8*)(kp + f * 16 * KVS), k1 = *(const LAS bf16x8*)(kp + f * 16 * KVS + 64);
        s[f] = MFMA16(k0, qf0, ((f32x4){0.f, 0.f, 0.f, 0.f})); s[f] = MFMA16(k1, qf1, s[f]); }
    float mx = sink2;
#pragma unroll
    for (int f = 0; f < NF; ++f)
#pragma unroll
        for (int r = 0; r < 4; ++r) { const int slot = slot0 + 16 * f + r; const float v = (slot >= slot_lo && slot <= slot_hi) ? s[f][r] : -INFINITY; s[f][r] = v; mx = fmaxf(mx, v); }
    mx = fmaxf(mx, __shfl_xor(mx, 16)); mx = fmaxf(mx, __shfl_xor(mx, 32));
    float l = 0.f;
#pragma unroll
    for (int f = 0; f < NF; ++f)
#pragma unroll
        for (int r = 0; r < 4; ++r) { const float p = __builtin_amdgcn_exp2f(s[f][r] - mx); s[f][r] = p; l += p; }
    l = xs4(l) + __builtin_amdgcn_exp2f(sink2 - mx);
#pragma unroll
    for (int d0 = 0; d0 < 4; ++d0) o[d0] = (f32x4){0.f, 0.f, 0.f, 0.f};
#pragma unroll
    for (int kk = 0; kk < (NF + 1) / 2; ++kk) { const int f0 = 2 * kk, f1 = (2 * kk + 1 < NF) ? 2 * kk + 1 : f0; const bool two = (2 * kk + 1 < NF);
        v4u pw; pw.x = cvtpk(s[f0][0], s[f0][1]); pw.y = cvtpk(s[f0][2], s[f0][3]); pw.z = two ? cvtpk(s[f1][0], s[f1][1]) : 0u; pw.w = two ? cvtpk(s[f1][2], s[f1][3]) : 0u;
        const bf16x8 pb = __builtin_bit_cast(bf16x8, pw);
#pragma unroll
        for (int d0 = 0; d0 < 4; ++d0) { const s16x4 lo = vtr(vp + f0 * 16 * KVS + d0 * 32), hi = vtr(vp + f1 * 16 * KVS + d0 * 32);
            const bf16x8 va = (bf16x8){lo[0], lo[1], lo[2], lo[3], hi[0], hi[1], hi[2], hi[3]};
            o[d0] = MFMA16(va, pb, o[d0]); } }
    const float inv = 1.0f / l;
#pragma unroll
    for (int d0 = 0; d0 < 4; ++d0) o[d0] = o[d0] * inv;
}

__device__ __forceinline__ void p4_attn_unit(Frame& F, int b, int j) {
    const bf16* Z = (const bf16*)(F.ws + WS_Z); bf16* AO = (bf16*)(F.ws + WS_AO);
    LAS unsigned char* Kl = F.lds; LAS unsigned char* Vl = F.lds + 2 * 192 * KVS; LAS float* xch = (LAS float*)(F.lds + XCH_OFF);
    const int lane = F.lane, w = F.wave, g = lane >> 4, ql = lane & 15;
    const int kb0 = 64 * j - 128;
    bf16x8 qfr[4][2];
#pragma unroll
    for (int qf = 0; qf < 4; ++qf) { const size_t m = (size_t)b * 4096 + 64 * j + 16 * qf + ql;
        qfr[qf][0] = *(const GAS bf16x8*)(Z + m * DIN + ZQ + w * 64 + 8 * g); qfr[qf][1] = *(const GAS bf16x8*)(Z + m * DIN + ZQ + w * 64 + 32 + 8 * g); }
    const float sink2 = F.in[10][w] * LOG2E_F;
    {
        v4u st[12];
#pragma unroll
        for (int it = 0; it < 12; ++it) { const int i = F.tid + it * (NWAVES * 64), slot = i >> 5, within = i & 31, pos = kb0 + slot;
            st[it] = (v4u){0u, 0u, 0u, 0u};
            if (pos >= 0) st[it] = *(const GAS v4u*)(Z + (size_t)(b * 4096 + pos) * DIN + ZK + within * 8); }
#pragma unroll
        for (int it = 0; it < 12; ++it) { const int i = F.tid + it * (NWAVES * 64), slot = i >> 5, within = i & 31;
            LAS unsigned char* dst = ((within & 16) ? Vl : Kl) + ((within >> 3) & 1) * (192 * KVS) + slot * KVS + (within & 7) * 16;
            *(LAS v4u*)dst = st[it]; }
    }
    __syncthreads();
    const int kvh = w >> 2;
    LAS const unsigned char* Kb = Kl + kvh * (192 * KVS); LAS const unsigned char* Vb = Vl + kvh * (192 * KVS);
    const int smin = (kb0 < 0) ? -kb0 : 0;
    f32x4 o[4][4];
#pragma unroll
    for (int qf = 0; qf < 4; ++qf) {
        const int lo = 16 * qf + ql + 1;
        attn_core<9>(o[qf], qfr[qf][0], qfr[qf][1], Kb + (16 * qf + ql) * KVS + 16 * g, Vb + (16 * qf + 4 * g + (ql >> 2)) * KVS + 8 * (ql & 3), 16 * qf + 4 * g, lo > smin ? lo : smin, 16 * qf + ql + 128, sink2);
        float q = 0.f;
#pragma unroll
        for (int d0 = 0; d0 < 4; ++d0) q += (o[qf][d0][0] * o[qf][d0][0] + o[qf][d0][1] * o[qf][d0][1]) + (o[qf][d0][2] * o[qf][d0][2] + o[qf][d0][3] * o[qf][d0][3]);
        q = xs4(q);
        if (g == 0) xch[(16 * qf + ql) * 8 + w] = q;
    }
    const float* ga = F.in[14]; f32x4 gn[4];
#pragma unroll
    for (int d0 = 0; d0 < 4; ++d0) gn[d0] = *(const GAS f32x4*)(ga + w * 64 + 16 * d0 + 4 * g);
    __syncthreads();
#pragma unroll
    for (int qf = 0; qf < 4; ++qf) {
        const f32x4 t0 = *(const LAS f32x4*)(xch + (16 * qf + ql) * 8), t1 = *(const LAS f32x4*)(xch + (16 * qf + ql) * 8 + 4);
        const float tot = ((t0[0] + t0[1]) + (t0[2] + t0[3])) + ((t1[0] + t1[1]) + (t1[2] + t1[3]));
        const float ra = __builtin_amdgcn_rsqf(tot * (1.0f / 512.0f) + EPS);
        const size_t m = (size_t)b * 4096 + 64 * j + 16 * qf + ql;
#pragma unroll
        for (int d0 = 0; d0 < 4; ++d0) { const int col = w * 64 + 16 * d0 + 4 * g; const f32x4 v = o[qf][d0] * ra * gn[d0];
            v2u pk; pk.x = cvtpk(v[0], v[1]); pk.y = cvtpk(v[2], v[3]); *(GAS v2u*)(AO + m * DM + col) = pk; }
    }
    __syncthreads();
}

template <int HALF, bool STAGE_ONLY = false> __device__ __forceinline__ void p4_gmlp_unit(Frame& F, int b, int n) {
    const bf16* Z = (const bf16*)(F.ws + WS_Z); bf16* AO = (bf16*)(F.ws + WS_AO); const float* ssv = (const float*)(F.ws + WS_SSV); const bf16* tril = (const bf16*)(F.ws + WS_TRIL);
    LAS unsigned char* Gl = F.lds; LAS float* xch = (LAS float*)(F.lds + XCH_OFF); LAS float* rst = xch + 512;
    const int lane = F.lane, w = F.wave, g = lane >> 4, ql = lane & 15;
    constexpr int NS = 64 * (HALF + 1); const size_t m0 = (size_t)b * 4096 + 128 * n;
    v2u wf[4][4][2]; v2u uf[4][4]; float bias[4];
    if (!STAGE_ONLY)
#pragma unroll
    for (int tf = 0; tf < 4; ++tf) { const int tc = 64 * HALF + 16 * tf + ql; constexpr int dummy = 0; (void)dummy;
        const int nfr = 4 * HALF + tf + 1, npair = (nfr + 1) >> 1;
        const bf16* wrow = tril + ((size_t)w * 128 + tc) * 128 + 4 * g;
#pragma unroll
        for (int kk = 0; kk < 4; ++kk) if (kk < npair) { wf[tf][kk][0] = *(const GAS v2u*)(wrow + 32 * kk); wf[tf][kk][1] = (2 * kk + 1 < nfr) ? *(const GAS v2u*)(wrow + 32 * kk + 16) : (v2u){0u, 0u}; }
#pragma unroll
        for (int d0 = 0; d0 < 4; ++d0) uf[tf][d0] = *(const GAS v2u*)(Z + (m0 + tc) * DIN + ZU + w * 64 + 16 * d0 + 4 * g);
        bias[tf] = F.in[13][w * 128 + tc];
#if PROBE == 15
        for (int rr = 0; rr < 3; ++rr) { asm volatile("" ::: "memory");
#pragma unroll
        for (int kk = 0; kk < 4; ++kk) if (kk < npair) { v2u t0 = *(const GAS v2u*)(wrow + 32 * kk); v2u t1 = *(const GAS v2u*)(wrow + 32 * kk + 16); asm volatile("" :: "v"(t0), "v"(t1)); }
#pragma unroll
        for (int d0 = 0; d0 < 4; ++d0) { v2u t2 = *(const GAS v2u*)(Z + (m0 + tc) * DIN + ZU + w * 64 + 16 * d0 + 4 * g); asm volatile("" :: "v"(t2)); } }
#endif
        }
    if (F.tid < NS) { const size_t m = m0 + F.tid; const f32x4 p0 = *(const GAS f32x4*)(ssv + m * 8), p1 = *(const GAS f32x4*)(ssv + m * 8 + 4);
        rst[F.tid] = __builtin_amdgcn_rsqf((((p0[0] + p0[1]) + (p0[2] + p0[3])) + ((p1[0] + p1[1]) + (p1[2] + p1[3]))) * (1.0f / 512.0f) + EPS); }
    {
        const int cc = F.tid & 63; const f32x4 gv0 = *(const GAS f32x4*)(F.in[11] + 8 * cc), gv1 = *(const GAS f32x4*)(F.in[11] + 8 * cc + 4);
        const bool wout = (n == 31 && HALF == 1); float* ogp = F.out + O_GP;
        v4u raw[NS / 8];
#pragma unroll
        for (int it = 0; it < NS / 8; ++it) raw[it] = *(const GAS v4u*)(Z + (m0 + w + 8 * it) * DIN + ZG + 8 * cc);
        __syncthreads();
#pragma unroll
        for (int it = 0; it < NS / 8; ++it) { const int sr = w + 8 * it; const float rs = rst[sr];
            const f32x4 a = (f32x4){bf_lo(raw[it].x), bf_hi(raw[it].x), bf_lo(raw[it].y), bf_hi(raw[it].y)} * rs * gv0, c = (f32x4){bf_lo(raw[it].z), bf_hi(raw[it].z), bf_lo(raw[it].w), bf_hi(raw[it].w)} * rs * gv1;
            v4u pk; pk.x = cvtpk(a[0], a[1]); pk.y = cvtpk(a[2], a[3]); pk.z = cvtpk(c[0], c[1]); pk.w = cvtpk(c[2], c[3]);
            *(LAS v4u*)(Gl + sr * GVS + cc * 16) = pk;
            if (wout) { float* op = ogp + ((size_t)b * 128 + sr) * 512 + 8 * cc; *(GAS f32x4*)op = a; *(GAS f32x4*)(op + 4) = c; } }
    }
    __syncthreads();
    if (STAGE_ONLY) return;
    f32x4 y[4][4];
#pragma unroll
    for (int tf = 0; tf < 4; ++tf) {
        const int nfr = 4 * HALF + tf + 1, npair = (nfr + 1) >> 1;
        f32x4 acc[4];
#pragma unroll
        for (int d0 = 0; d0 < 4; ++d0) acc[d0] = (f32x4){0.f, 0.f, 0.f, 0.f};
        LAS const unsigned char* gp = Gl + (4 * g + (ql >> 2)) * GVS + (w * 64 + 4 * (ql & 3)) * 2;
#pragma unroll
        for (int kk = 0; kk < 4; ++kk) if (kk < npair) { const int f0 = 2 * kk; const int f1 = (2 * kk + 1 < nfr) ? f0 + 1 : f0;
            const bf16x8 pb = __builtin_bit_cast(bf16x8, ((v4u){wf[tf][kk][0].x, wf[tf][kk][0].y, wf[tf][kk][1].x, wf[tf][kk][1].y}));
#pragma unroll
            for (int d0 = 0; d0 < 4; ++d0) { const s16x4 lo = vtr(gp + f0 * 16 * GVS + d0 * 32), hi = vtr(gp + f1 * 16 * GVS + d0 * 32);
                const bf16x8 va = (bf16x8){lo[0], lo[1], lo[2], lo[3], hi[0], hi[1], hi[2], hi[3]};
                acc[d0] = MFMA16(va, pb, acc[d0]); } }
        float q = 0.f;
#pragma unroll
        for (int d0 = 0; d0 < 4; ++d0) { const v2u ur = uf[tf][d0];
            const f32x4 uu = (f32x4){bf_lo(ur.x), bf_hi(ur.x), bf_lo(ur.y), bf_hi(ur.y)}; const f32x4 v = uu * (acc[d0] + bias[tf]); y[tf][d0] = v;
            q += (v[0] * v[0] + v[1] * v[1]) + (v[2] * v[2] + v[3] * v[3]); }
        q = xs4(q);
        if (g == 0) xch[(16 * tf + ql) * 8 + w] = q;
    }
    const float* gg = F.in[15]; f32x4 gn[4];
#pragma unroll
    for (int d0 = 0; d0 < 4; ++d0) gn[d0] = *(const GAS f32x4*)(gg + w * 64 + 16 * d0 + 4 * g);
    __syncthreads();
#pragma unroll
    for (int tf = 0; tf < 4; ++tf) {
        const f32x4 t0 = *(const LAS f32x4*)(xch + (16 * tf + ql) * 8), t1 = *(const LAS f32x4*)(xch + (16 * tf + ql) * 8 + 4);
        const float tot = ((t0[0] + t0[1]) + (t0[2] + t0[3])) + ((t1[0] + t1[1]) + (t1[2] + t1[3]));
        const float rg = __builtin_amdgcn_rsqf(tot * (1.0f / 512.0f) + EPS);
        const size_t mt = m0 + 64 * HALF + 16 * tf + ql;
#pragma unroll
        for (int d0 = 0; d0 < 4; ++d0) { const int col = w * 64 + 16 * d0 + 4 * g; const f32x4 v = y[tf][d0] * rg * gn[d0];
            v2u pk; pk.x = cvtpk(v[0], v[1]); pk.y = cvtpk(v[2], v[3]); *(GAS v2u*)(AO + mt * DM + 512 + col) = pk;
#if PROBE == 14
            asm volatile("" ::: "memory"); *(GAS v2u*)(AO + mt * DM + 512 + col) = pk; asm volatile("" ::: "memory"); *(GAS v2u*)(AO + mt * DM + 512 + col) = pk; asm volatile("" ::: "memory"); *(GAS v2u*)(AO + mt * DM + 512 + col) = pk;
#endif
            }
    }
    __syncthreads();
}

__device__ __forceinline__ void p4_sample_attn(Frame& F, int b) {
    const bf16* Z = (const bf16*)(F.ws + WS_Z); bf16* AO = (bf16*)(F.ws + WS_AO);
    LAS unsigned char* Kl = F.lds; LAS unsigned char* Vl = F.lds + 2 * 144 * KVS; LAS float* xch = (LAS float*)(F.lds + XCH_OFF);
    const int lane = F.lane, w = F.wave, g = lane >> 4, ql = lane & 15, tid = F.tid;
    const float* ck = F.in[2] + (size_t)b * 128 * 128; const float* cv = F.in[3] + (size_t)b * 128 * 128;
    float* oks = F.out + O_KS + (size_t)b * 128 * 128; float* ovs = F.out + O_VS + (size_t)b * 128 * 128;
    const int t_q = ql & 3, hq = ql >> 2;
    bf16x8 qf0 = (bf16x8){0, 0, 0, 0, 0, 0, 0, 0}, qf1 = qf0; float sink2 = 0.f; f32x4 gn[4];
    if (w < 2) { const int h = 4 * w + hq; const size_t m = (size_t)MP + 4 * b + t_q; sink2 = F.in[10][h] * LOG2E_F;
        qf0 = *(const GAS bf16x8*)(Z + m * DIN + ZQ + h * 64 + 8 * g); qf1 = *(const GAS bf16x8*)(Z + m * DIN + ZQ + h * 64 + 32 + 8 * g);
#pragma unroll
        for (int d0 = 0; d0 < 4; ++d0) gn[d0] = *(const GAS f32x4*)(F.in[14] + h * 64 + 16 * d0 + 4 * g); }
    {
        f32x4 vk[8], vv[8];
#pragma unroll
        for (int it = 0; it < 8; ++it) { const int i = tid + it * (NWAVES * 64); vk[it] = *(const GAS f32x4*)(ck + i * 4); vv[it] = *(const GAS f32x4*)(cv + i * 4); }
        if (tid < 128) { const int t = tid >> 5, within = tid & 31;
            const v4u v = *(const GAS v4u*)(Z + (size_t)(MP + 4 * b + t) * DIN + ZK + within * 8);
            LAS unsigned char* dst = ((within & 16) ? Vl : Kl) + ((within >> 3) & 1) * (144 * KVS) + (128 + t) * KVS + (within & 7) * 16; *(LAS v4u*)dst = v; }
        else if (tid < 128 + 384) { const int e = tid - 128, r = e >> 5, within = e & 31;
            LAS unsigned char* dst = ((within & 16) ? Vl : Kl) + ((within >> 3) & 1) * (144 * KVS) + (132 + r) * KVS + (within & 7) * 16; *(LAS v4u*)dst = (v4u){0u, 0u, 0u, 0u}; }
#pragma unroll
        for (int it = 0; it < 8; ++it) { const int i = tid + it * (NWAVES * 64), jr = i >> 5, c = i & 31, kvh = c >> 4, d4 = (c & 15) * 4;
            v2u pk; pk.x = cvtpk(vk[it][0], vk[it][1]); pk.y = cvtpk(vk[it][2], vk[it][3]); *(LAS v2u*)(Kl + kvh * (144 * KVS) + jr * KVS + d4 * 2) = pk;
            v2u pv; pv.x = cvtpk(vv[it][0], vv[it][1]); pv.y = cvtpk(vv[it][2], vv[it][3]); *(LAS v2u*)(Vl + kvh * (144 * KVS) + jr * KVS + d4 * 2) = pv;
            if (jr >= 4) { *(GAS f32x4*)(oks + (jr - 4) * 128 + c * 4) = vk[it]; *(GAS f32x4*)(ovs + (jr - 4) * 128 + c * 4) = vv[it]; } }
    }
    __syncthreads();
    f32x4 o[4];
    if (w < 2) {
        attn_core<9>(o, qf0, qf1, Kl + w * (144 * KVS) + ql * KVS + 16 * g, Vl + w * (144 * KVS) + (4 * g + (ql >> 2)) * KVS + 8 * (ql & 3), 4 * g, t_q + 1, t_q + 128, sink2);
        float q = 0.f;
#pragma unroll
        for (int d0 = 0; d0 < 4; ++d0) q += (o[d0][0] * o[d0][0] + o[d0][1] * o[d0][1]) + (o[d0][2] * o[d0][2] + o[d0][3] * o[d0][3]);
        q = xs4(q); q += __shfl_xor(q, 4); q += __shfl_xor(q, 8);
        if (lane < 4) xch[lane * 8 + w] = q;
    }
    __syncthreads();
    if (w < 2) {
        const int h = 4 * w + hq; const size_t m = (size_t)MP + 4 * b + t_q;
        const float tot = xch[t_q * 8] + xch[t_q * 8 + 1]; const float ra = __builtin_amdgcn_rsqf(tot * (1.0f / 512.0f) + EPS);
#pragma unroll
        for (int d0 = 0; d0 < 4; ++d0) { const int col = h * 64 + 16 * d0 + 4 * g; const f32x4 v = o[d0] * ra * gn[d0];
            v2u pk; pk.x = cvtpk(v[0], v[1]); pk.y = cvtpk(v[2], v[3]); *(GAS v2u*)(AO + m * DM + col) = pk; }
    }
    __syncthreads();
}
__device__ __forceinline__ void p4_sample_gmlp(Frame& F, int b) {
    const bf16* Z = (const bf16*)(F.ws + WS_Z); bf16* AO = (bf16*)(F.ws + WS_AO); const float* ssv = (const float*)(F.ws + WS_SSV);
    LAS float* xch2 = (LAS float*)(F.lds + XCH_OFF) + 512;
    const int lane = F.lane, w = F.wave, c = F.tid; const size_t mb = (size_t)MP + 4 * b;
    float gvn[4], yg[4], uu[4], raw[4], bs[4], wm[4][4]; f32x4 p0[4], p1[4];
    const float gvc = F.in[11][c], ggc = F.in[15][c]; float* ogs = F.out + O_GS + (size_t)b * 4 * 512;
#pragma unroll
    for (int s = 0; s < 4; ++s) { p0[s] = *(const GAS f32x4*)(ssv + (mb + s) * 8); p1[s] = *(const GAS f32x4*)(ssv + (mb + s) * 8 + 4);
        raw[s] = __builtin_bit_cast(float, (unsigned)Z[(mb + s) * DIN + ZG + c] << 16); uu[s] = __builtin_bit_cast(float, (unsigned)Z[(mb + s) * DIN + ZU + c] << 16); bs[s] = F.in[13][w * 128 + s];
#pragma unroll
        for (int k = 0; k <= s; ++k) wm[s][k] = F.in[12][((size_t)w * 128 + s) * 128 + k]; }
#pragma unroll
    for (int s = 0; s < 4; ++s) { const float rs = __builtin_amdgcn_rsqf((((p0[s][0] + p0[s][1]) + (p0[s][2] + p0[s][3])) + ((p1[s][0] + p1[s][1]) + (p1[s][2] + p1[s][3]))) * (1.0f / 512.0f) + EPS);
        gvn[s] = raw[s] * rs * gvc; ogs[s * 512 + c] = gvn[s]; }
#pragma unroll
    for (int t = 0; t < 4; ++t) { float mix = bs[t];
#pragma unroll
        for (int s = 0; s <= t; ++s) mix += wm[t][s] * gvn[s];
        yg[t] = uu[t] * mix; const float q = wave_sum(yg[t] * yg[t]); if (lane == 0) xch2[t * 8 + w] = q; }
    __syncthreads();
#pragma unroll
    for (int t = 0; t < 4; ++t) { float tot = 0.f;
#pragma unroll
        for (int k = 0; k < 8; ++k) tot += xch2[t * 8 + k];
        const float rg = __builtin_amdgcn_rsqf(tot * (1.0f / 512.0f) + EPS); AO[(mb + t) * DM + 512 + c] = (bf16)f2bf(yg[t] * rg * ggc); }
    __syncthreads();
}

__device__ __forceinline__ void p8_final(Frame& F) {
    const int gw = F.vcu * NWAVES + F.wave, NGW = F.G * NWAVES; const float* ss3 = (const float*)(F.ws + WS_SS3); const GAS f32x4* gr = (const GAS f32x4*)F.in[21] + F.lane;
    f32x4 gn[4];
#pragma unroll
    for (int j = 0; j < 4; ++j) gn[j] = gr[64 * j];
    for (int m = gw; m < M; m += NGW) {
        const f32x4 p0 = *(const GAS f32x4*)(ss3 + (size_t)m * 16), p1 = *(const GAS f32x4*)(ss3 + (size_t)m * 16 + 4), p2 = *(const GAS f32x4*)(ss3 + (size_t)m * 16 + 8), p3 = *(const GAS f32x4*)(ss3 + (size_t)m * 16 + 12);
        const float tot = (((p0[0] + p0[1]) + (p0[2] + p0[3])) + ((p1[0] + p1[1]) + (p1[2] + p1[3]))) + (((p2[0] + p2[1]) + (p2[2] + p2[3])) + ((p3[0] + p3[1]) + (p3[2] + p3[3])));
        const float rs = 1.0f / sqrtf(tot * (1.0f / DM) + EPS);
        GAS f32x4* xr = (GAS f32x4*)(F.out + (size_t)m * DM) + F.lane;
#pragma unroll
        for (int j = 0; j < 4; ++j) xr[64 * j] = xr[64 * j] * rs * gn[j];
    }
}

struct Args { const float* in[22]; float* out; unsigned char* ws; int ph_lo, ph_hi, li, pad; };
__global__ void __launch_bounds__(NWAVES * 64, 2) mk_fwd(Args args) {
    extern __shared__ __attribute__((aligned(16))) unsigned char lds[];
    Frame F;
    F.lds = (LAS unsigned char*)lds;
    F.MISC = (volatile LAS unsigned*)(F.lds + MISC_OFF);
    F.tid = threadIdx.x; F.lane = F.tid & 63; F.wave = __builtin_amdgcn_readfirstlane(F.tid >> 6);
    F.G = gridDim.x; { const int bx = blockIdx.x; F.vcu = (F.G % 8 == 0) ? (bx % 8) * (F.G / 8) + bx / 8 : bx; }
    unsigned char* ws = args.ws; F.ws = ws; F.out = args.out; F.pad = args.pad;
    F.ctl = (gu32*)(ws + WS_CTL);
#pragma unroll
    for (int i = 0; i < 22; ++i) F.in[i] = args.in[i];
    for (int u = F.tid; u < (LDS_BYTES - LDSCTL_OFF) / 4; u += NWAVES * 64) ((LAS unsigned*)(F.lds + LDSCTL_OFF))[u] = 0u;
    __syncthreads();
    XcdBarrier bar; bar.bar = (unsigned*)(F.ctl + CW_BAR); bar.x = 0; bar.st = nullptr;
    if (N_LAUNCHES == 1) bar = xcd_barrier_post((unsigned*)(F.ctl + CW_BAR), F.MISC + 8);
#define GRID_BAR() do { if (N_LAUNCHES == 1) xcd_barrier(bar); } while (0)
    const int lo = args.ph_lo, hi = args.ph_hi;
#define IN(k) (lo <= (k) && (k) < hi)
#define BOTH(k) (IN(k) && IN((k) + 1))
    bf16* XB = (bf16*)(ws + WS_XB); bf16* HB = (bf16*)(ws + WS_H); bf16* ZB = (bf16*)(ws + WS_Z); bf16* AO = (bf16*)(ws + WS_AO);
    float* SS1 = (float*)(ws + WS_SS1); float* SS2 = (float*)(ws + WS_SS2); float* SS3 = (float*)(ws + WS_SS3); float* SSV = (float*)(ws + WS_SSV);
    float* X = F.out + O_Y;

    if (IN(0)) { p0_prologue(F);
#if PROBE == 5
        GRID_BAR(); p0_prologue(F);
#endif
        if (BOTH(0)) GRID_BAR(); }
    if (IN(1)) {
        pg8::Gemm g{XB, (const bf16*)(ws + WS_WGU1), M, NGU, DM}; pg8::StaticOrder S; S.init(M, NGU, F.G, (int)blockIdx.x);
        pg8::EpiSwiGLU<false> E{HB, FF, nullptr};
        pg8::gemm_phase<pg8::EpiSwiGLU<false>, pg8::StaticOrder, PG8_ALIGN, PG8_SP2>(F.lds + RING_OFF, g, S, E);
#if PROBE == 1
        GRID_BAR(); pg8::gemm_phase<pg8::EpiSwiGLU<false>, pg8::StaticOrder, PG8_ALIGN, PG8_SP2>(F.lds + RING_OFF, g, S, E);
#endif
        if (BOTH(1)) GRID_BAR();
    }
    if (IN(2)) {
        pg8::Gemm g{HB, (const bf16*)(ws + WS_WD1), MP, DM, FF}; pg8::StaticOrder S; S.init(MP, DM, F.G, (int)blockIdx.x);
        pg8::EpiRes<0, false, true> E{F.in[0], F.in[1] - (size_t)MP * DM, MP / 256, nullptr, XB, SS1, 0.5f, nullptr};
        pg8::gemm_phase<pg8::EpiRes<0, false, true>, pg8::StaticOrder, PG8_ALIGN, PG8_SP2>(F.lds + RING_OFF, g, S, E);
        for (int t = F.vcu; t < 256; t += F.G) mini_gemm<FF>(F.lds + RING_OFF, HB + (size_t)MP * FF, (const bf16*)(ws + WS_WD1), MP, t, E, F.tid, F.wave, F.lane);
#if PROBE == 2
        GRID_BAR(); pg8::gemm_phase<pg8::EpiRes<0, false, true>, pg8::StaticOrder, PG8_ALIGN, PG8_SP2>(F.lds + RING_OFF, g, S, E);
#endif
#if PROBE == 3
        GRID_BAR(); for (int t = F.vcu; t < 256; t += F.G) mini_gemm<FF>(F.lds + RING_OFF, HB + (size_t)MP * FF, (const bf16*)(ws + WS_WD1), MP, t, E, F.tid, F.wave, F.lane);
#endif
        if (BOTH(2)) GRID_BAR();
    }
    if (IN(3)) {
        pg8::Gemm g{XB, (const bf16*)(ws + WS_WIN), M, DIN, DM}; pg8::StaticOrder S; S.init(M, DIN, F.G, (int)blockIdx.x);
        pg8::EpiInProj E{ZB, SS1, (const float*)(ws + WS_ROPE), SSV, F.out, (long)O_KP, (long)O_KS, (long)(O_VP - O_KP), (long)(O_VS - O_KS)};
        pg8::gemm_phase<pg8::EpiInProj, pg8::StaticOrder, PG8_ALIGN, PG8_SP2>(F.lds + RING_OFF, g, S, E);
#if PROBE == 7
        GRID_BAR(); pg8::gemm_phase<pg8::EpiInProj, pg8::StaticOrder, PG8_ALIGN, PG8_SP2>(F.lds + RING_OFF, g, S, E);
#endif
        if (BOTH(3)) GRID_BAR();
    }
    if (IN(4)) {
        for (int u = F.vcu; u < 256; u += F.G) { if (u < 128) p4_sample_attn(F, u); else p4_sample_gmlp(F, u - 128); }
#if PROBE == 10
        for (int rep = 0; rep < 2 + args.pad; ++rep)
#endif
        for (int u = F.vcu; u < 256; u += F.G) p4_attn_unit(F, u >> 6, u & 63);
#if PROBE == 11
        for (int rep = 0; rep < 2 + args.pad; ++rep)
#endif
#if PROBE == 12
        for (int u = F.vcu; u < 256; u += F.G) { if (u & 1) p4_gmlp_unit<1, true>(F, u >> 6, (u & 63) >> 1); else p4_gmlp_unit<0, true>(F, u >> 6, (u & 63) >> 1); }
#endif
        for (int u = F.vcu; u < 256; u += F.G) { if (u & 1) p4_gmlp_unit<1>(F, u >> 6, (u & 63) >> 1); else p4_gmlp_unit<0>(F, u >> 6, (u & 63) >> 1); }
#if PROBE == 6
        GRID_BAR();
        for (int u = F.vcu; u < 256; u += F.G) { if (u < 128) p4_sample_attn(F, u); else p4_sample_gmlp(F, u - 128); }
        for (int u = F.vcu; u < 256; u += F.G) p4_attn_unit(F, u >> 6, u & 63);
        for (int u = F.vcu; u < 256; u += F.G) { if (u & 1) p4_gmlp_unit<1>(F, u >> 6, (u & 63) >> 1); else p4_gmlp_unit<0>(F, u >> 6, (u & 63) >> 1); }
#endif
#if PROBE == 8
        GRID_BAR();
        for (int u = F.vcu; u < 256; u += F.G) p4_attn_unit(F, u >> 6, u & 63);
#endif
#if PROBE == 9
        GRID_BAR();
        for (int u = F.vcu; u < 256; u += F.G) { if (u & 1) p4_gmlp_unit<1>(F, u >> 6, (u & 63) >> 1); else p4_gmlp_unit<0>(F, u >> 6, (u & 63) >> 1); }
#endif
        if (BOTH(4)) GRID_BAR();
    }
    if (IN(5)) {
        pg8::Gemm g{AO, (const bf16*)(ws + WS_WOUT), MP, DM, DM}; pg8::StaticOrder S; S.init(MP, DM, F.G, (int)blockIdx.x);
        pg8::EpiRes<1, false, true> E{nullptr, nullptr, 1 << 30, nullptr, XB, SS2, 1.0f, XB};
#if PROBE == 20
        { pg8::EpiRes<1, false, true> E2{nullptr, nullptr, 1 << 30, nullptr, (bf16*)(ws + 180 * MiB), (float*)(ws + 220 * MiB), 1.0f, XB};
          pg8::gemm_phase<pg8::EpiRes<1, false, true>, pg8::StaticOrder, PG8_ALIGN, PG8_SP2>(F.lds + RING_OFF, g, S, E2); GRID_BAR(); }
#endif
#if PROBE == 21
        { pg8::EpiRes<1, false, true> E2{nullptr, nullptr, 1 << 30, nullptr, (bf16*)(ws + 180 * MiB), (float*)(ws + 220 * MiB), 1.0f, XB};
          for (int t = F.vcu; t < 256; t += F.G) mini_gemm<DM>(F.lds + RING_OFF, AO + (size_t)MP * DM, (const bf16*)(ws + WS_WOUT), MP, t, E2, F.tid, F.wave, F.lane); GRID_BAR(); }
#endif
        pg8::gemm_phase<pg8::EpiRes<1, false, true>, pg8::StaticOrder, PG8_ALIGN, PG8_SP2>(F.lds + RING_OFF, g, S, E);
        for (int t = F.vcu; t < 256; t += F.G) mini_gemm<DM>(F.lds + RING_OFF, AO + (size_t)MP * DM, (const bf16*)(ws + WS_WOUT), MP, t, E, F.tid, F.wave, F.lane);
        if (BOTH(5)) GRID_BAR();
    }
    if (IN(6)) {
        pg8::Gemm g{XB, (const bf16*)(ws + WS_WGU2), M, NGU, DM}; pg8::StaticOrder S; S.init(M, NGU, F.G, (int)blockIdx.x);
        pg8::EpiSwiGLU<true> E{HB, FF, SS2};
        pg8::gemm_phase<pg8::EpiSwiGLU<true>, pg8::StaticOrder, PG8_ALIGN, PG8_SP2>(F.lds + RING_OFF, g, S, E);
#if PROBE == 22
        GRID_BAR(); pg8::gemm_phase<pg8::EpiSwiGLU<true>, pg8::StaticOrder, PG8_ALIGN, PG8_SP2>(F.lds + RING_OFF, g, S, E);
#endif
        if (BOTH(6)) GRID_BAR();
    }
    if (IN(7)) {
        pg8::Gemm g{HB, (const bf16*)(ws + WS_WD2), MP, DM, FF}; pg8::StaticOrder S; S.init(MP, DM, F.G, (int)blockIdx.x);
        pg8::EpiRes<1, true, false> E{nullptr, nullptr, 1 << 30, X, XB, SS3, 0.5f, XB};
        pg8::gemm_phase<pg8::EpiRes<1, true, false>, pg8::StaticOrder, PG8_ALIGN, PG8_SP2>(F.lds + RING_OFF, g, S, E);
        for (int t = F.vcu; t < 256; t += F.G) mini_gemm<FF>(F.lds + RING_OFF, HB + (size_t)MP * FF, (const bf16*)(ws + WS_WD2), MP, t, E, F.tid, F.wave, F.lane);
#if PROBE == 18
        GRID_BAR(); pg8::gemm_phase<pg8::EpiRes<1, true, false>, pg8::StaticOrder, PG8_ALIGN, PG8_SP2>(F.lds + RING_OFF, g, S, E);
#endif
#if PROBE == 19
        GRID_BAR(); for (int t = F.vcu; t < 256; t += F.G) mini_gemm<FF>(F.lds + RING_OFF, HB + (size_t)MP * FF, (const bf16*)(ws + WS_WD2), MP, t, E, F.tid, F.wave, F.lane);
#endif
        if (BOTH(7)) GRID_BAR();
    }
#if PROBE == 23
    GRID_BAR(); GRID_BAR(); GRID_BAR(); GRID_BAR();
#endif
    if (IN(8)) p8_final(F);
#undef IN
#undef BOTH
}

extern "C" void kernel_launch(void* const* d_in, const int* in_sizes, int n_in, void* d_out, int out_size, void* d_ws, size_t ws_size, hipStream_t stream) {
    static int grid = 0;
    if (grid == 0) {
        if (n_in != 22 || in_sizes[0] != MP * DM || out_size != (int)O_END || ws_size < WS_END) { fprintf(stderr, "kernel_launch: unexpected shapes (n_in %d, in0 %d, out %d, ws %zu); nothing launched\n", n_in, n_in > 0 ? in_sizes[0] : -1, out_size, ws_size); grid = -1; return; }
        int dev = 0, cus = 0, per_cu = 0;
        if (hipGetDevice(&dev) != hipSuccess || hipDeviceGetAttribute(&cus, hipDeviceAttributeMultiprocessorCount, dev) != hipSuccess) { fprintf(stderr, "kernel_launch: device query failed\n"); grid = -1; return; }
        if (hipFuncSetAttribute((const void*)mk_fwd, hipFuncAttributeMaxDynamicSharedMemorySize, LDS_BYTES) != hipSuccess) { fprintf(stderr, "kernel_launch: hipFuncSetAttribute failed\n"); grid = -1; return; }
        if (hipOccupancyMaxActiveBlocksPerMultiprocessor(&per_cu, (const void*)mk_fwd, NWAVES * 64, LDS_BYTES) != hipSuccess || per_cu < 1) { fprintf(stderr, "kernel_launch: occupancy query reports %d workgroups per CU\n", per_cu); grid = -1; (void)hipGetLastError(); return; }
        (void)hipGetLastError();
        grid = cus;
    }
    if (grid < 0) return;
    if (hipMemsetAsync((char*)d_ws + WS_CTL, 0, CTL_ZERO_BYTES, stream) != hipSuccess) { fprintf(stderr, "kernel_launch: hipMemsetAsync failed\n"); return; }
    Args a{};
    for (int i = 0; i < 22; ++i) a.in[i] = (const float*)d_in[i];
    a.out = (float*)d_out; a.ws = (unsigned char*)d_ws;
    for (int li = 0; li < N_LAUNCHES; ++li) {
        a.ph_lo = (N_LAUNCHES == 1) ? 0 : li; a.ph_hi = (N_LAUNCHES == 1) ? N_PHASES : li + 1; a.li = li;
        hipLaunchKernelGGL(mk_fwd, dim3(grid), dim3(NWAVES * 64), LDS_BYTES, stream, a);
        const hipError_t le = hipPeekAtLastError();
        if (le != hipSuccess) { fprintf(stderr, "kernel_launch: launch %d failed: %s\n", li, hipGetErrorName(le)); break; }
    }
}
```
